# Optimizing an MI355X kernel written in HIP

```python
import math
import jax
import jax.numpy as jnp
from jax import lax
import numpy as np

D_MODEL = 2048
BATCH = 2
SEQ = 16384
DEPTH = 4

ROPE_THETA = 10000.0
RMS_EPS = 1e-6
DIFF_SUBLN_EPS = 1e-5
A_HEAD_DIM = 128
A_HEADS = D_MODEL // 256
A_WIDTH = A_HEADS * A_HEAD_DIM
MOBA_BLOCK = 256
MOBA_TOPK = 3
MOBA_Q_CHUNK = 64
B_HEAD_DIM = 128
B_HEADS = D_MODEL // 512
B_WIDTH = 2 * B_HEADS * B_HEAD_DIM
DENSE_Q_BLOCK = 128
EVEN_IN = 3 * A_WIDTH + 3 * B_WIDTH
EVEN_OUT = A_WIDTH + B_WIDTH
C_HEAD_DIM = 64
C_Q_HEADS = D_MODEL // C_HEAD_DIM
C_KV_HEADS = C_Q_HEADS // 8
C_WINDOW = 128
C_Q_WIDTH = C_Q_HEADS * C_HEAD_DIM
C_KV_WIDTH = C_KV_HEADS * C_HEAD_DIM
ODD_IN = C_Q_WIDTH + 2 * C_KV_WIDTH
FFN_HIDDEN = -(-8 * D_MODEL // (3 * 256)) * 256
N_EVEN = (DEPTH + 1) // 2
N_ODD = DEPTH // 2
N_MOD = 6

kernel_name = "hybrid_moba_diff_swa_adaln_trunk"


def rms_norm(x, w=None, eps=RMS_EPS):
    xf = x.astype(jnp.float32)
    y = xf * lax.rsqrt(jnp.mean(xf * xf, axis=-1, keepdims=True) + eps)
    if w is not None:
        y = y * w.astype(jnp.float32)
    return y.astype(x.dtype)


def rope_tables(seq, dim):
    pos = jnp.arange(seq, dtype=jnp.float32)
    inv_freq = ROPE_THETA ** (-jnp.arange(0, dim, 2, dtype=jnp.float32) / dim)
    ang = pos[:, None] * inv_freq[None, :]
    return jnp.cos(ang), jnp.sin(ang)


def apply_rope(x, cos, sin):
    xf = x.astype(jnp.float32)
    half = xf.shape[-1] // 2
    x1, x2 = xf[..., :half], xf[..., half:]
    out = jnp.concatenate([x1 * cos - x2 * sin, x2 * cos + x1 * sin], axis=-1)
    return out.astype(x.dtype)


def split_heads(t, n_heads, head_dim):
    bsz, seq, _ = t.shape
    return t.reshape(bsz, seq, n_heads, head_dim).transpose(0, 2, 1, 3)


def merge_heads(t):
    bsz, nh, seq, dh = t.shape
    return t.transpose(0, 2, 1, 3).reshape(bsz, seq, nh * dh)


def lambda_init_fn(layer):
    return 0.8 - 0.6 * math.exp(-0.3 * layer)


def moba_attention(q, k, v):
    bsz, nh, seq, dh = q.shape
    nb = -(-seq // MOBA_BLOCK)
    padded = nb * MOBA_BLOCK
    if padded != seq:
        pad = ((0, 0), (0, 0), (0, padded - seq), (0, 0))
        q, k, v = jnp.pad(q, pad), jnp.pad(k, pad), jnp.pad(v, pad)
    topk = min(MOBA_TOPK, nb)
    n_chunks = padded // MOBA_Q_CHUNK
    scale = dh ** -0.5
    kb = k.reshape(bsz, nh, nb, MOBA_BLOCK, dh)
    vb = v.reshape(bsz, nh, nb, MOBA_BLOCK, dh)
    k_mean = jnp.mean(kb.astype(jnp.float32), axis=3)
    q_chunks = jnp.moveaxis(q.reshape(bsz, nh, n_chunks, MOBA_Q_CHUNK, dh), 2, 0)
    b_idx = jnp.arange(bsz)[:, None, None, None]
    h_idx = jnp.arange(nh)[None, :, None, None]
    blk_ids = jnp.arange(nb)
    q_offs = jnp.arange(MOBA_Q_CHUNK)
    k_offs = jnp.arange(MOBA_BLOCK)

    def one_chunk(args):
        qi, ci = args
        q_pos = ci * MOBA_Q_CHUNK + q_offs
        own = (ci * MOBA_Q_CHUNK) // MOBA_BLOCK
        gate = jnp.einsum('bhqd,bhnd->bhqn', qi.astype(jnp.float32), k_mean)
        gate = jnp.where(blk_ids < own, gate, -jnp.inf)
        _, sel = lax.top_k(gate, topk)
        sel_valid = sel < own
        k_sel = kb[b_idx, h_idx, sel]
        v_sel = vb[b_idx, h_idx, sel]
        s_sel = jnp.einsum('bhqd,bhqjkd->bhqjk', qi, k_sel).astype(jnp.float32) * scale
        s_sel = jnp.where(sel_valid[..., None], s_sel, -jnp.inf)
        k_own = lax.dynamic_index_in_dim(kb, own, axis=2, keepdims=False)
        v_own = lax.dynamic_index_in_dim(vb, own, axis=2, keepdims=False)
        s_own = jnp.einsum('bhqd,bhkd->bhqk', qi, k_own).astype(jnp.float32) * scale
        k_pos = own * MOBA_BLOCK + k_offs
        s_own = jnp.where(k_pos[None, :] <= q_pos[:, None], s_own, -jnp.inf)
        logits = jnp.concatenate(
            [s_sel.reshape(bsz, nh, MOBA_Q_CHUNK, topk * MOBA_BLOCK), s_own], axis=-1)
        p = jax.nn.softmax(logits, axis=-1).astype(v.dtype)
        p_sel = p[..., :topk * MOBA_BLOCK].reshape(bsz, nh, MOBA_Q_CHUNK, topk, MOBA_BLOCK)
        p_own = p[..., topk * MOBA_BLOCK:]
        return (jnp.einsum('bhqjk,bhqjkd->bhqd', p_sel, v_sel)
                + jnp.einsum('bhqk,bhkd->bhqd', p_own, v_own))

    out = lax.map(one_chunk, (q_chunks, jnp.arange(n_chunks)))
    out = jnp.moveaxis(out, 0, 2).reshape(bsz, nh, padded, dh)
    return out[:, :, :seq]


def diff_attention(q, k, v, lam):
    bsz, n2, seq, dh = q.shape
    nh = n2 // 2
    n_blocks = seq // DENSE_Q_BLOCK
    scale = dh ** -0.5
    k_pos = jnp.arange(seq)
    q_offs = jnp.arange(DENSE_Q_BLOCK)
    q_blocks = jnp.moveaxis(q.reshape(bsz, n2, n_blocks, DENSE_Q_BLOCK, dh), 2, 0)

    def one_block(args):
        qi, bi = args
        q_pos = bi * DENSE_Q_BLOCK + q_offs
        s = jnp.einsum('bhqd,bhkd->bhqk', qi, k).astype(jnp.float32) * scale
        s = jnp.where(k_pos[None, :] <= q_pos[:, None], s, -jnp.inf)
        p = jax.nn.softmax(s, axis=-1).reshape(bsz, nh, 2, DENSE_Q_BLOCK, seq)
        w = (p[:, :, 0] - lam * p[:, :, 1]).astype(v.dtype)
        return jnp.einsum('bhqk,bhkd->bhqd', w, v)

    out = lax.map(one_block, (q_blocks, jnp.arange(n_blocks)))
    return jnp.moveaxis(out, 0, 2).reshape(bsz, nh, seq, v.shape[-1])


def sliding_window_sink_attention(q, k, v, sinks):
    bsz, n_q, seq, dh = q.shape
    n_kv = k.shape[1]
    grp = n_q // n_kv
    n_blocks = seq // C_WINDOW
    scale = dh ** -0.5
    pad = ((0, 0), (0, 0), (C_WINDOW, 0), (0, 0))
    kp, vp = jnp.pad(k, pad), jnp.pad(v, pad)
    q_blocks = jnp.moveaxis(q.reshape(bsz, n_kv, grp, n_blocks, C_WINDOW, dh), 3, 0)
    sink_logits = sinks.astype(jnp.float32).reshape(1, n_kv, grp, 1, 1)
    q_offs = jnp.arange(C_WINDOW)
    k_offs = jnp.arange(2 * C_WINDOW)

    def one_block(args):
        qi, bi = args
        kw = lax.dynamic_slice_in_dim(kp, bi * C_WINDOW, 2 * C_WINDOW, axis=2)
        vw = lax.dynamic_slice_in_dim(vp, bi * C_WINDOW, 2 * C_WINDOW, axis=2)
        q_pos = bi * C_WINDOW + q_offs
        k_pos = (bi - 1) * C_WINDOW + k_offs
        rel = q_pos[:, None] - k_pos[None, :]
        mask = (rel >= 0) & (rel < C_WINDOW) & (k_pos[None, :] >= 0)
        s = jnp.einsum('bkgqd,bksd->bkgqs', qi, kw).astype(jnp.float32) * scale
        s = jnp.where(mask, s, -jnp.inf)
        sink = jnp.broadcast_to(sink_logits, s.shape[:-1] + (1,))
        p = jax.nn.softmax(jnp.concatenate([s, sink], axis=-1), axis=-1)[..., :-1]
        return jnp.einsum('bkgqs,bksd->bkgqd', p.astype(v.dtype), vw)

    out = lax.map(one_block, (q_blocks, jnp.arange(n_blocks)))
    return jnp.moveaxis(out, 0, 3).reshape(bsz, n_q, seq, dh)


def even_mixer(h, w_in, w_out, lam_vecs, subln_w, lambda_init, cos_r, sin_r):
    proj = h @ w_in
    splits = [A_WIDTH, 2 * A_WIDTH, 3 * A_WIDTH,
              3 * A_WIDTH + B_WIDTH, 3 * A_WIDTH + 2 * B_WIDTH]
    aq, ak, av, bq, bk, bv = jnp.split(proj, splits, axis=-1)
    aq = apply_rope(split_heads(aq, A_HEADS, A_HEAD_DIM), cos_r, sin_r)
    ak = apply_rope(split_heads(ak, A_HEADS, A_HEAD_DIM), cos_r, sin_r)
    av = split_heads(av, A_HEADS, A_HEAD_DIM)
    ya = moba_attention(aq, ak, av)
    bq = apply_rope(split_heads(bq, 2 * B_HEADS, B_HEAD_DIM), cos_r, sin_r)
    bk = apply_rope(split_heads(bk, 2 * B_HEADS, B_HEAD_DIM), cos_r, sin_r)
    bv = split_heads(bv, B_HEADS, 2 * B_HEAD_DIM)
    lv = lam_vecs.astype(jnp.float32)
    lam = (jnp.exp(jnp.sum(lv[0] * lv[1])) - jnp.exp(jnp.sum(lv[2] * lv[3]))
           + lambda_init)
    yb = diff_attention(bq, bk, bv, lam)
    yb = rms_norm(yb, subln_w, DIFF_SUBLN_EPS) * (1.0 - lambda_init)
    y = jnp.concatenate([merge_heads(ya), merge_heads(yb)], axis=-1)
    return y @ w_out


def odd_mixer(h, w_in, b_in, w_out, b_out, sinks, cos_r, sin_r):
    proj = h @ w_in + b_in
    q, k, v = jnp.split(proj, [C_Q_WIDTH, C_Q_WIDTH + C_KV_WIDTH], axis=-1)
    q = apply_rope(split_heads(q, C_Q_HEADS, C_HEAD_DIM), cos_r, sin_r)
    k = apply_rope(split_heads(k, C_KV_HEADS, C_HEAD_DIM), cos_r, sin_r)
    v = split_heads(v, C_KV_HEADS, C_HEAD_DIM)
    y = sliding_window_sink_attention(q, k, v, sinks)
    return merge_heads(y) @ w_out + b_out


def swiglu(h, w_in, w_out):
    gate, up = jnp.split(h @ w_in, 2, axis=-1)
    return (jax.nn.silu(gate) * up) @ w_out


def setup_inputs(seed: int = 0) -> dict:
    key = jax.random.key(seed)
    ks = jax.random.split(key, 17)

    def nrm(k, shape, s):
        return jax.random.normal(k, shape, jnp.float32) * s

    return {
        "x": nrm(ks[0], (BATCH, SEQ, D_MODEL), 1.0),
        "c": nrm(ks[1], (BATCH, D_MODEL), 1.0),
        "ada_w": nrm(ks[2], (DEPTH, D_MODEL, N_MOD * D_MODEL), 0.5 * D_MODEL ** -0.5),
        "ada_b": nrm(ks[3], (DEPTH, N_MOD * D_MODEL), 0.02),
        "ab_w_in": nrm(ks[4], (N_EVEN, D_MODEL, EVEN_IN), D_MODEL ** -0.5),
        "ab_w_out": nrm(ks[5], (N_EVEN, EVEN_OUT, D_MODEL), EVEN_OUT ** -0.5),
        "diff_lambda": nrm(ks[6], (N_EVEN, 4, B_HEAD_DIM), 0.1),
        "diff_subln": 1.0 + nrm(ks[7], (N_EVEN, 2 * B_HEAD_DIM), 0.02),
        "swa_w_in": nrm(ks[8], (N_ODD, D_MODEL, ODD_IN), D_MODEL ** -0.5),
        "swa_b_in": nrm(ks[9], (N_ODD, ODD_IN), 0.02),
        "swa_w_out": nrm(ks[10], (N_ODD, C_Q_WIDTH, D_MODEL), C_Q_WIDTH ** -0.5),
        "swa_b_out": nrm(ks[11], (N_ODD, D_MODEL), 0.02),
        "swa_sinks": nrm(ks[12], (N_ODD, C_Q_HEADS), 0.5),
        "ffn_w_in": nrm(ks[13], (DEPTH, D_MODEL, 2 * FFN_HIDDEN), D_MODEL ** -0.5),
        "ffn_w_out": nrm(ks[14], (DEPTH, FFN_HIDDEN, D_MODEL), FFN_HIDDEN ** -0.5),
        "final_norm": 1.0 + nrm(ks[15], (D_MODEL,), 0.02),
    }


def reference(x, c, ada_w, ada_b, ab_w_in, ab_w_out, diff_lambda, diff_subln,
              swa_w_in, swa_b_in, swa_w_out, swa_b_out, swa_sinks,
              ffn_w_in, ffn_w_out, final_norm):
    seq = x.shape[1]
    cos_ab, sin_ab = rope_tables(seq, A_HEAD_DIM)
    cos_c, sin_c = rope_tables(seq, C_HEAD_DIM)
    cond = jax.nn.silu(c.astype(jnp.float32)).astype(x.dtype)
    for layer in range(DEPTH):
        mod = cond @ ada_w[layer] + ada_b[layer]
        sh1, sc1, g1, sh2, sc2, g2 = jnp.split(mod[:, None, :], N_MOD, axis=-1)
        h = rms_norm(x) * (1.0 + sc1) + sh1
        i = layer // 2
        if layer % 2 == 0:
            y = even_mixer(h, ab_w_in[i], ab_w_out[i], diff_lambda[i], diff_subln[i],
                           lambda_init_fn(layer), cos_ab, sin_ab)
        else:
            y = odd_mixer(h, swa_w_in[i], swa_b_in[i], swa_w_out[i], swa_b_out[i],
                          swa_sinks[i], cos_c, sin_c)
        x = x + g1 * y
        h = rms_norm(x) * (1.0 + sc2) + sh2
        x = x + g2 * swiglu(h, ffn_w_in[layer], ffn_w_out[layer])
    return rms_norm(x, final_norm)
```

```cpp
#include <hip/hip_runtime.h>
#include <cstdio>
#include <cstdint>
#include <cmath>
namespace pg8 {
#define PG8_LAS __attribute__((address_space(3)))
typedef unsigned short bf16_t;
typedef short bf16x8 __attribute__((ext_vector_type(8)));
typedef float f32x4 __attribute__((ext_vector_type(4)));
typedef unsigned u32x4 __attribute__((ext_vector_type(4)));
constexpr int BM = 256, BK = 64, HALF = 128, HTB = HALF * BK * 2  , STAGE_BYTES = 8 * HTB, NXCD = 8, WGM = 8;

__host__ __device__ __forceinline__ int lds_byte(int r, int c) { const int st = (r >> 4) * 2 + (c >> 5), rr = r & 15, cc = c & 31, ob = rr * 64 + cc * 2; return st * 1024 + (ob ^ (((ob >> 9) & 1) << 5)); }
__host__ __device__ __forceinline__ void stage_rc(int b, int& R, int& C) { const int st = b / 1024, sb = b % 1024, swz = sb ^ (((sb >> 9) & 1) << 5); R = (st >> 1) * 16 + swz / 64; C = (st & 1) * 32 + (swz % 64) / 2; }
__host__ __device__ __forceinline__ int perm32(int rho) { const int n = rho >> 4, i = rho & 15; return 8 * (i >> 2) + 4 * n + (i & 3); }

struct Unit { int pm, pn; };
struct Gemm { const bf16_t* A; const bf16_t* Bt; int M, N, K; };

struct StaticOrder {
    int nM, nN, nwg, G, c;
    __host__ __device__ void init(int M, int N, int G_, int c_) { nM = M / BM; nN = N / BM; nwg = nM * nN; G = G_; c = c_; }
    __host__ __device__ bool next(int i, Unit& u) const {
        const long L = (long)i * G + c; if (L >= nwg) return false;
        int wgid = (int)L; { const int q = nwg / NXCD, r = nwg % NXCD, xcd = wgid % NXCD, off = wgid / NXCD; wgid = (xcd < r ? xcd * (q + 1) : r * (q + 1) + (xcd - r) * q) + off; }
        const int nig = WGM * nN, gid = wgid / nig, fm = gid * WGM, gsz = (nM - fm) < WGM ? (nM - fm) : WGM;
        u.pm = fm + ((wgid % nig) % gsz); u.pn = (wgid % nig) / gsz; return true;
    }
    __device__ __forceinline__ void a_ready(const Unit&) const {}
    __device__ __forceinline__ void done(const Unit&) const {}
};

__device__ __forceinline__ unsigned cvt_pk_bf16(float lo, float hi) { unsigned r; asm volatile("v_cvt_pk_bf16_f32 %0, %1, %2" : "=v"(r) : "v"(lo), "v"(hi)); return r; }
typedef float f32x2 __attribute__((ext_vector_type(2)));
typedef unsigned u32x2 __attribute__((ext_vector_type(2)));
constexpr int SEQ_LEN = 16384;

__host__ __device__ __forceinline__ int rope128_slot(int d) { return 8 * ((d & 63) >> 2) + 4 * (d >> 6) + (d & 3); }
__host__ __device__ __forceinline__ int rope64_slot(int d) { return 8 * ((d & 31) >> 2) + 4 * (d >> 5) + (d & 3); }
__host__ __device__ __forceinline__ int perm_even_in(int c) { const int region = c >> 10; if (region == 2 || region == 5) return c; return (c & ~127) + rope128_slot(c & 127); }
__host__ __device__ __forceinline__ int perm_odd_in(int c) { if (c >= 2304) return c; return (c & ~63) + rope64_slot(c & 63); }
__host__ __device__ __forceinline__ int perm_ffn_in(int c) { const int up = c >= 5632 ? 1 : 0; const int j = c - up * 5632; return 8 * (j >> 2) + 4 * up + (j & 3); }

__device__ __forceinline__ u32x2 pack4(f32x4 v) { u32x2 w; w.x = cvt_pk_bf16(v[0], v[1]); w.y = cvt_pk_bf16(v[2], v[3]); return w; }

struct EpiEvenIn {
    static constexpr bool PERM = true, AFTER_DRAIN = false;
    bf16_t* O; const float* cs; const float* sn;
    __device__ __forceinline__ void operator()(const f32x4 (&acc)[2][2][4][2], const Unit& u, int wr, int wc, int fr, int fq) const {
        const int row0 = u.pm * BM + wr * 64 + fr; const int region = u.pn >> 2;
        if (region != 2 && region != 5) {
            const int g4 = (4 * wc + fq) * 4;
#pragma unroll
            for (int ai = 0; ai < 2; ++ai)
#pragma unroll
                for (int m = 0; m < 4; ++m) { const int row = row0 + ai * HALF + m * 16; const int pos = row & (SEQ_LEN - 1);
                    const f32x4 c = *(const f32x4*)(cs + pos * 64 + g4), s = *(const f32x4*)(sn + pos * 64 + g4);
#pragma unroll
                    for (int bj = 0; bj < 2; ++bj) { const f32x4 x1 = acc[ai][bj][m][0], x2 = acc[ai][bj][m][1];
                        const f32x4 o1 = x1 * c - x2 * s, o2 = x2 * c + x1 * s;
                        bf16_t* p = O + (size_t)row * 6144 + u.pn * BM + bj * HALF + g4;
                        *(u32x2*)p = pack4(o1); *(u32x2*)(p + 64) = pack4(o2); } }
        } else {
            const int col0 = u.pn * BM + wc * 32 + 8 * fq;
#pragma unroll
            for (int ai = 0; ai < 2; ++ai)
#pragma unroll
                for (int m = 0; m < 4; ++m) { bf16_t* rowp = O + (size_t)(row0 + ai * HALF + m * 16) * 6144 + col0;
#pragma unroll
                    for (int bj = 0; bj < 2; ++bj) { const f32x4 v0 = acc[ai][bj][m][0], v1 = acc[ai][bj][m][1];
                        u32x4 w; w.x = cvt_pk_bf16(v0[0], v0[1]); w.y = cvt_pk_bf16(v0[2], v0[3]); w.z = cvt_pk_bf16(v1[0], v1[1]); w.w = cvt_pk_bf16(v1[2], v1[3]);
                        *(u32x4*)(rowp + bj * HALF) = w; } }
        }
    }
};
struct EpiOddIn {
    static constexpr bool PERM = true, AFTER_DRAIN = false;
    bf16_t* O; const float* cs; const float* sn; const float* bias;
    __device__ __forceinline__ void operator()(const f32x4 (&acc)[2][2][4][2], const Unit& u, int wr, int wc, int fr, int fq) const {
        const int row0 = u.pm * BM + wr * 64 + fr;
        if (u.pn < 9) {
            const int g4 = (4 * (wc & 1) + fq) * 4;
            const int hb0 = u.pn * BM + 64 * (wc >> 1);
            f32x4 b1[2], b2[2];
#pragma unroll
            for (int bj = 0; bj < 2; ++bj) { b1[bj] = *(const f32x4*)(bias + hb0 + bj * HALF + g4); b2[bj] = *(const f32x4*)(bias + hb0 + bj * HALF + 32 + g4); }
#pragma unroll
            for (int ai = 0; ai < 2; ++ai)
#pragma unroll
                for (int m = 0; m < 4; ++m) { const int row = row0 + ai * HALF + m * 16; const int pos = row & (SEQ_LEN - 1);
                    const f32x4 c = *(const f32x4*)(cs + pos * 32 + g4), s = *(const f32x4*)(sn + pos * 32 + g4);
#pragma unroll
                    for (int bj = 0; bj < 2; ++bj) { const f32x4 x1 = acc[ai][bj][m][0] + b1[bj], x2 = acc[ai][bj][m][1] + b2[bj];
                        const f32x4 o1 = x1 * c - x2 * s, o2 = x2 * c + x1 * s;
                        bf16_t* p = O + (size_t)row * 2560 + hb0 + bj * HALF + g4;
                        *(u32x2*)p = pack4(o1); *(u32x2*)(p + 32) = pack4(o2); } }
        } else {
            const int col0 = u.pn * BM + wc * 32 + 8 * fq;
            f32x4 bv[2][2];
#pragma unroll
            for (int bj = 0; bj < 2; ++bj)
#pragma unroll
                for (int n = 0; n < 2; ++n) bv[bj][n] = *(const f32x4*)(bias + col0 + bj * HALF + 4 * n);
#pragma unroll
            for (int ai = 0; ai < 2; ++ai)
#pragma unroll
                for (int m = 0; m < 4; ++m) { bf16_t* rowp = O + (size_t)(row0 + ai * HALF + m * 16) * 2560 + col0;
#pragma unroll
                    for (int bj = 0; bj < 2; ++bj) { const f32x4 v0 = acc[ai][bj][m][0] + bv[bj][0], v1 = acc[ai][bj][m][1] + bv[bj][1];
                        u32x4 w; w.x = cvt_pk_bf16(v0[0], v0[1]); w.y = cvt_pk_bf16(v0[2], v0[3]); w.z = cvt_pk_bf16(v1[0], v1[1]); w.w = cvt_pk_bf16(v1[2], v1[3]);
                        *(u32x4*)(rowp + bj * HALF) = w; } }
        }
    }
};
struct EpiFfnIn {
    static constexpr bool PERM = true, AFTER_DRAIN = false;
    bf16_t* O;
    __device__ __forceinline__ void operator()(const f32x4 (&acc)[2][2][4][2], const Unit& u, int wr, int wc, int fr, int fq) const {
        const int row0 = u.pm * BM + wr * 64 + fr; const int col0 = u.pn * HALF + 16 * wc + 4 * fq;
#pragma unroll
        for (int ai = 0; ai < 2; ++ai)
#pragma unroll
            for (int m = 0; m < 4; ++m) { bf16_t* rowp = O + (size_t)(row0 + ai * HALF + m * 16) * 5632 + col0;
#pragma unroll
                for (int bj = 0; bj < 2; ++bj) { const f32x4 g = acc[ai][bj][m][0], up = acc[ai][bj][m][1]; f32x4 h;
#pragma unroll
                    for (int i = 0; i < 4; ++i) { const float e = __builtin_amdgcn_exp2f(g[i] * -1.4426950408889634f); h[i] = g[i] * __builtin_amdgcn_rcpf(1.0f + e) * up[i]; }
                    *(u32x2*)(rowp + bj * 64) = pack4(h); } }
    }
};
struct EpiResid {
    static constexpr bool PERM = false, AFTER_DRAIN = false;
    const float* base; float* out; const float* gate0; const float* bias;
    __device__ __forceinline__ void operator()(const f32x4 (&acc)[2][2][4][2], const Unit& u, int wr, int wc, int fr, int fq) const {
        const int row0 = u.pm * BM + wr * 64 + fr, col0 = u.pn * BM + wc * 32 + 4 * fq;
        const float* gate = gate0 + (u.pm >= (SEQ_LEN / BM) ? 12288 : 0);
        f32x4 gv[2][2], bv[2][2];
#pragma unroll
        for (int bj = 0; bj < 2; ++bj)
#pragma unroll
            for (int n = 0; n < 2; ++n) { gv[bj][n] = *(const f32x4*)(gate + col0 + bj * HALF + n * 16); bv[bj][n] = bias ? *(const f32x4*)(bias + col0 + bj * HALF + n * 16) : (f32x4){0.f, 0.f, 0.f, 0.f}; }
#pragma unroll
        for (int ai = 0; ai < 2; ++ai)
#pragma unroll
            for (int m = 0; m < 4; ++m) { const size_t off = (size_t)(row0 + ai * HALF + m * 16) * 2048 + col0;
#pragma unroll
                for (int bj = 0; bj < 2; ++bj)
#pragma unroll
                    for (int n = 0; n < 2; ++n) { const f32x4 b = *(const f32x4*)(base + off + bj * HALF + n * 16);
                        *(f32x4*)(out + off + bj * HALF + n * 16) = b + gv[bj][n] * (acc[ai][bj][m][n] + bv[bj][n]); } }
    }
};
template <class Epi, class Sched, bool ALIGN_EPI = false, bool SP2 = false>
__device__ __forceinline__ void gemm_phase(PG8_LAS unsigned char* lds, const Gemm g, const Sched& S, const Epi& E, const int wv) {
    int lane; asm volatile("v_mbcnt_lo_u32_b32 %0, -1, 0\n\tv_mbcnt_hi_u32_b32 %0, -1, %0" : "=v"(lane));
    const int wid = wv, tid = wv * 64 + lane, wr = wid >> 2, wc = wid & 3, fr = lane & 15, fq = lane >> 4;
    const int K = g.K, nt = K / BK;
    unsigned voffA[2], voffB[2];
#pragma unroll
    for (int i = 0; i < 2; ++i) { int R, C; stage_rc(tid * 16 + i * 8192, R, C); const int Rb = Epi::PERM ? ((R & ~31) + perm32(R & 31)) : R;
        voffA[i] = (unsigned)(R * K + C) * 2u; voffB[i] = (unsigned)(Rb * K + C) * 2u; }
    const size_t kstep = (size_t)(BK * 2);
    const size_t hstep = (size_t)HALF * K * 2;
    const size_t tstep = 2 * hstep;
    const unsigned ldsw = (unsigned)wid * 1024u;
    const int aoff = lds_byte(wr * 64 + fr, fq * 8), boff = lds_byte(wc * 32 + fr, fq * 8);
#define PG8_SA(b, h) (((b) * 2 + (h)) * HTB)
#define PG8_SB(b, h) ((4 + (b) * 2 + (h)) * HTB)
#define PG8_STAGE(bufoff, gbase, voff) do { _Pragma("unroll") for (int _i = 0; _i < 2; ++_i) \
        __builtin_amdgcn_global_load_lds((const unsigned*)((const char*)(gbase) + (voff)[_i]), (PG8_LAS unsigned*)(lds + (bufoff) + ldsw + _i * 8192), 16, 0, 0); } while (0)
#define PG8_LDA(dst, b, h) do { _Pragma("unroll") for (int m = 0; m < 4; ++m) _Pragma("unroll") for (int k = 0; k < 2; ++k) dst[m][k] = *(const PG8_LAS bf16x8*)(lds + PG8_SA(b, h) + aoff + m * 2048 + k * 1024); } while (0)
#define PG8_LDB(dst, b, h) do { _Pragma("unroll") for (int n = 0; n < 2; ++n) _Pragma("unroll") for (int k = 0; k < 2; ++k) dst[n][k] = *(const PG8_LAS bf16x8*)(lds + PG8_SB(b, h) + boff + n * 2048 + k * 1024); } while (0)
#define PG8_MMA(ai, bj, At, Bt) do { __builtin_amdgcn_s_setprio(1); _Pragma("unroll") for (int m = 0; m < 4; ++m) _Pragma("unroll") for (int n = 0; n < 2; ++n) _Pragma("unroll") for (int k = 0; k < 2; ++k) \
        acc[ai][bj][m][n] = __builtin_amdgcn_mfma_f32_16x16x32_bf16(Bt[n][k], At[m][k], acc[ai][bj][m][n], 0, 0, 0); __builtin_amdgcn_s_setprio(0); } while (0)
#define PG8_WAIT_V(n) asm volatile("s_waitcnt vmcnt(" #n ")" ::: "memory")
#define PG8_WAIT_L(n) asm volatile("s_waitcnt lgkmcnt(" #n ")" ::: "memory")
#define PG8_BAR __builtin_amdgcn_s_barrier()
#define PG8_SCHED __builtin_amdgcn_sched_barrier(0)
    Unit cur, nxt; int ui = 0;
    if (!S.next(0, cur)) return;
    f32x4 acc[2][2][4][2];
#pragma unroll
    for (int a = 0; a < 2; ++a)
#pragma unroll
        for (int b = 0; b < 2; ++b)
#pragma unroll
            for (int m = 0; m < 4; ++m)
#pragma unroll
                for (int n = 0; n < 2; ++n) acc[a][b][m][n] = (f32x4){0.f, 0.f, 0.f, 0.f};
    bf16x8 At[4][2], B0[2][2], B1[2][2];
    const char* cA = (const char*)g.A + (size_t)cur.pm * tstep; const char* cB = (const char*)g.Bt + (size_t)cur.pn * tstep;
    S.a_ready(cur);
    if constexpr (SP2) {
        PG8_STAGE(PG8_SB(0, 0), cB, voffB); PG8_STAGE(PG8_SB(0, 1), cB + hstep, voffB); PG8_STAGE(PG8_SA(0, 0), cA, voffA); PG8_STAGE(PG8_SA(0, 1), cA + hstep, voffA);
        if (wr == 1) PG8_BAR;
        PG8_WAIT_V(2); PG8_BAR;
        PG8_STAGE(PG8_SB(1, 0), cB + kstep, voffB); PG8_STAGE(PG8_SA(1, 0), cA + kstep, voffA); PG8_STAGE(PG8_SB(1, 1), cB + hstep + kstep, voffB);
        PG8_WAIT_V(6); PG8_BAR;
    } else {
        PG8_STAGE(PG8_SB(0, 0), cB, voffB); PG8_STAGE(PG8_SA(0, 0), cA, voffA); PG8_STAGE(PG8_SB(0, 1), cB + hstep, voffB); PG8_STAGE(PG8_SA(0, 1), cA + hstep, voffA);
        if (wr == 1) PG8_BAR;
        PG8_WAIT_V(4); PG8_BAR;
        PG8_STAGE(PG8_SB(1, 0), cB + kstep, voffB); PG8_STAGE(PG8_SA(1, 0), cA + kstep, voffA); PG8_STAGE(PG8_SB(1, 1), cB + hstep + kstep, voffB);
        PG8_WAIT_V(6); PG8_BAR;
    }
    for (;;) {
        const bool has_next = S.next(ui + 1, nxt);
        const char* nA = has_next ? (const char*)g.A + (size_t)nxt.pm * tstep : cA; const char* nB = has_next ? (const char*)g.Bt + (size_t)nxt.pn * tstep : cB;
        for (int t = 0; t < nt; t += 2) {
            const bool last = (t == nt - 2);
            const char* a1 = cA + (size_t)(t + 1) * kstep;
            const char* a2 = last ? nA : cA + (size_t)(t + 2) * kstep; const char* b2 = last ? nB : cB + (size_t)(t + 2) * kstep;
            const char* a3 = a2 + kstep; const char* b3 = b2 + kstep;
            if (last && has_next) S.a_ready(nxt);
            if constexpr (SP2) {
            PG8_LDB(B0, 0, 0); PG8_LDB(B1, 0, 1); PG8_SCHED; PG8_LDA(At, 0, 0); PG8_STAGE(PG8_SA(1, 1), a1 + hstep, voffA);
            PG8_WAIT_V(8); PG8_WAIT_L(0); PG8_BAR; PG8_MMA(0, 0, At, B0); PG8_MMA(0, 1, At, B1); PG8_BAR; PG8_SCHED;
            PG8_LDA(At, 0, 1); PG8_STAGE(PG8_SB(0, 0), b2, voffB); PG8_STAGE(PG8_SB(0, 1), b2 + hstep, voffB); PG8_STAGE(PG8_SA(0, 0), a2, voffA);
            PG8_WAIT_V(8); PG8_WAIT_L(0); PG8_BAR; PG8_MMA(1, 0, At, B0); PG8_MMA(1, 1, At, B1); PG8_BAR; PG8_SCHED;
            PG8_LDB(B0, 1, 0); PG8_LDB(B1, 1, 1); PG8_SCHED; PG8_LDA(At, 1, 0); PG8_STAGE(PG8_SA(0, 1), a2 + hstep, voffA);
            PG8_WAIT_V(8); PG8_WAIT_L(0); PG8_BAR; PG8_MMA(0, 0, At, B0); PG8_MMA(0, 1, At, B1); PG8_BAR; PG8_SCHED;
            PG8_LDA(At, 1, 1); PG8_STAGE(PG8_SB(1, 0), b3, voffB); PG8_STAGE(PG8_SB(1, 1), b3 + hstep, voffB); PG8_STAGE(PG8_SA(1, 0), a3, voffA);
            PG8_WAIT_V(8); PG8_WAIT_L(0); PG8_BAR; PG8_MMA(1, 0, At, B0); PG8_MMA(1, 1, At, B1); PG8_BAR; PG8_SCHED;
            } else {
            PG8_LDB(B0, 0, 0); PG8_SCHED; PG8_LDA(At, 0, 0); PG8_STAGE(PG8_SA(1, 1), a1 + hstep, voffA);
            PG8_WAIT_L(8); PG8_BAR; PG8_WAIT_L(0); PG8_MMA(0, 0, At, B0); PG8_BAR; PG8_SCHED;
            PG8_LDB(B1, 0, 1); PG8_STAGE(PG8_SB(0, 0), b2, voffB);
            PG8_BAR; PG8_WAIT_L(0); PG8_MMA(0, 1, At, B1); PG8_BAR;
            PG8_LDA(At, 0, 1); PG8_STAGE(PG8_SA(0, 0), a2, voffA);
            PG8_BAR; PG8_WAIT_L(0); PG8_MMA(1, 0, At, B0); PG8_BAR; PG8_SCHED;
            PG8_STAGE(PG8_SB(0, 1), b2 + hstep, voffB);
            PG8_WAIT_V(6); PG8_BAR; PG8_MMA(1, 1, At, B1); PG8_BAR;
            PG8_LDB(B0, 1, 0); PG8_SCHED; PG8_LDA(At, 1, 0); PG8_STAGE(PG8_SA(0, 1), a2 + hstep, voffA);
            PG8_WAIT_L(8); PG8_BAR; PG8_WAIT_L(0); PG8_MMA(0, 0, At, B0); PG8_BAR; PG8_SCHED;
            PG8_LDB(B1, 1, 1); PG8_STAGE(PG8_SB(1, 0), b3, voffB);
            PG8_BAR; PG8_WAIT_L(0); PG8_MMA(0, 1, At, B1); PG8_BAR;
            PG8_LDA(At, 1, 1); PG8_STAGE(PG8_SA(1, 0), a3, voffA);
            PG8_BAR; PG8_WAIT_L(0); PG8_MMA(1, 0, At, B0); PG8_BAR; PG8_SCHED;
            PG8_STAGE(PG8_SB(1, 1), b3 + hstep, voffB);
            PG8_WAIT_V(6); PG8_BAR; PG8_MMA(1, 1, At, B1); PG8_BAR;
            }
        }
        if constexpr (ALIGN_EPI) { if (wr == 0) PG8_BAR; }
        if constexpr (!Epi::AFTER_DRAIN) { E(acc, cur, wr, wc, fr, fq); S.done(cur); }
        if (!has_next) break;
#pragma unroll
        for (int a = 0; a < 2; ++a)
#pragma unroll
            for (int b = 0; b < 2; ++b)
#pragma unroll
                for (int m = 0; m < 4; ++m)
#pragma unroll
                    for (int n = 0; n < 2; ++n) acc[a][b][m][n] = (f32x4){0.f, 0.f, 0.f, 0.f};
        cur = nxt; cA = nA; cB = nB; ++ui;
        if constexpr (ALIGN_EPI) { if (wr == 1) PG8_BAR; }
    }
    PG8_WAIT_V(0);
    if constexpr (!ALIGN_EPI) { if (wr == 0) PG8_BAR; }
    PG8_BAR;
    if constexpr (Epi::AFTER_DRAIN) { E.fused(acc, cur, wr, wc, fr, fq, lds, wid, lane); S.done(cur); }
#undef PG8_SA
#undef PG8_SB
#undef PG8_STAGE
#undef PG8_LDA
#undef PG8_LDB
#undef PG8_MMA
#undef PG8_WAIT_V
#undef PG8_WAIT_L
#undef PG8_BAR
#undef PG8_SCHED
}
}

namespace att {
typedef unsigned short bf16_t;
typedef short bf16x8 __attribute__((ext_vector_type(8)));
typedef short s16x4 __attribute__((ext_vector_type(4)));
typedef float f32x16 __attribute__((ext_vector_type(16)));
typedef float f32x4 __attribute__((ext_vector_type(4)));
typedef unsigned u32x4 __attribute__((ext_vector_type(4)));
constexpr int D = 128;
constexpr float SCALE = 0.08838834764831845f;
constexpr float THR = 8.f;
constexpr int NW = 8, QBLK = 32, KVBLK = 64, QB = NW * QBLK;
constexpr int SHM_V = KVBLK * D * 2, SHM_K = KVBLK * D * 2;
constexpr int LDS_BYTES = 2 * SHM_V + 2 * SHM_K + NW * 64 * 4;

#define KSWZ(row, colB) ((row) * 256 + ((colB) ^ (((row) & 7) << 4)))
#define SBAR() __builtin_amdgcn_sched_barrier(0)
__device__ __forceinline__ int v_st(int k, int c) { const int kk = (k & ~0xC) | ((k & 4) << 1) | ((k & 8) >> 1); return ((kk >> 3) * 4 + (c >> 5)) * 512 + ((kk & 7) * 32 + (c & 31)) * 2; }
__device__ __forceinline__ int v_rd_base(int lane) { return ((lane & 3) << 3) | (((lane >> 2) & 3) << 6) | (((lane >> 4) & 1) << 5) | (((lane >> 5) & 1) << 8); }
constexpr int v_rd_off(int d0, int ks, int half) { return d0 * 512 + ks * 4096 + half * 2048; }
__device__ __forceinline__ int crow(int r, int hi) { return (r & 3) + 8 * (r >> 2) + 4 * hi; }
__device__ __forceinline__ unsigned cvtpk(float lo, float hi) { unsigned r; asm volatile("v_cvt_pk_bf16_f32 %0, %1, %2" : "=v"(r) : "v"(lo), "v"(hi)); return r; }
__device__ __forceinline__ bf16x8 load8(const bf16_t* p) { return *reinterpret_cast<const bf16x8*>(p); }
__device__ __forceinline__ void mask_tile(f32x16& p0, f32x16& p1, int dq, unsigned W) {
    const float NEG = -__builtin_inff();
#pragma unroll
    for (int r = 0; r < 16; ++r) {
        const int c = (r & 3) + 8 * (r >> 2);
        if ((unsigned)(dq - c) >= W) p0[r] = NEG;
        if ((unsigned)(dq - c - 32) >= W) p1[r] = NEG;
    }
}
__device__ __forceinline__ void mask_all(f32x16& p0, f32x16& p1, bool kill) {
    const float NEG = -__builtin_inff();
#pragma unroll
    for (int r = 0; r < 16; ++r) { if (kill) p0[r] = NEG; if (kill) p1[r] = NEG; }
}
__device__ __forceinline__ void partialSM(f32x16& p0, f32x16& p1, float& m_reg, float& mn, float& alpha) {
    float pmax = p0[0]; for (int r = 1; r < 16; ++r) pmax = fmaxf(pmax, p0[r]); for (int r = 0; r < 16; ++r) pmax = fmaxf(pmax, p1[r]);
    { auto rr = __builtin_amdgcn_permlane32_swap(__float_as_uint(pmax), __float_as_uint(pmax), false, false);
      pmax = fmaxf(__uint_as_float(rr[0]), __uint_as_float(rr[1])); }
    constexpr float C2 = 1.4426950408889634f * SCALE;
    if (__builtin_expect(__all((pmax - m_reg) * SCALE <= THR), 1)) { mn = m_reg; alpha = 1.f; }
    else { mn = fmaxf(m_reg, pmax); alpha = __builtin_amdgcn_exp2f((m_reg - mn) * C2); m_reg = mn; }
    const float mnL = -mn * C2;
    for (int r = 0; r < 16; ++r) p0[r] = fmaf(p0[r], C2, mnL); for (int r = 0; r < 16; ++r) p1[r] = fmaf(p1[r], C2, mnL);
    for (int r = 0; r < 16; ++r) p0[r] = __builtin_amdgcn_exp2f(p0[r]);
}
__device__ __forceinline__ void finishSM(f32x16& p0, f32x16& p1, float alpha, float& l_reg, bf16x8& pa0, bf16x8& pa1, bf16x8& pa2, bf16x8& pa3) {
    for (int r = 0; r < 16; ++r) p1[r] = __builtin_amdgcn_exp2f(p1[r]);
    float ps = 0; for (int r = 0; r < 16; ++r) ps += p0[r]; for (int r = 0; r < 16; ++r) ps += p1[r];
    { auto rr = __builtin_amdgcn_permlane32_swap(__float_as_uint(ps), __float_as_uint(ps), false, false);
      ps = __uint_as_float(rr[0]) + __uint_as_float(rr[1]); }
    l_reg = l_reg * alpha + ps;
#define PK4(P, B_, OUT) do { unsigned a0 = cvtpk(P[B_+0], P[B_+1]), a1 = cvtpk(P[B_+2], P[B_+3]);                          \
        unsigned b0 = cvtpk(P[B_+4], P[B_+5]), b1 = cvtpk(P[B_+6], P[B_+7]);                                             \
        auto r0 = __builtin_amdgcn_permlane32_swap(a0, b0, false, false); auto r1 = __builtin_amdgcn_permlane32_swap(a1, b1, false, false); \
        u32x4 w = {r0[0], r1[0], r0[1], r1[1]}; OUT = *reinterpret_cast<bf16x8*>(&w); } while (0)
    PK4(p0, 0, pa0); PK4(p0, 8, pa1); PK4(p1, 0, pa2); PK4(p1, 8, pa3);
#undef PK4
}
template <int KB>
__device__ __forceinline__ void qkt(f32x16& p0, f32x16& p1, const char* K_lds, int r32, int hi, const bf16x8* qr) {
    p0 = f32x16{}; p1 = f32x16{};
    const char* kb[4];
#pragma unroll
    for (int dd = 0; dd < 4; ++dd) kb[dd] = K_lds + KB * SHM_K + KSWZ(r32, (dd * 16 + hi * 8) * 2);
#pragma unroll
    for (int d0 = 0; d0 < 8; ++d0) { const char* a = kb[d0 & 3] + (d0 >> 2) * 128;
        bf16x8 b0 = *reinterpret_cast<const bf16x8*>(a);
        bf16x8 b1 = *reinterpret_cast<const bf16x8*>(a + 32 * 256);
        p0 = __builtin_amdgcn_mfma_f32_32x32x16_bf16(b0, qr[d0], p0, 0, 0, 0);
        p1 = __builtin_amdgcn_mfma_f32_32x32x16_bf16(b1, qr[d0], p1, 0, 0, 0); }
}
template <int VB>
__device__ __forceinline__ void pv_tile(f32x16* o, int vb0, bf16x8 pa0, bf16x8 pa1, bf16x8 pa2, bf16x8 pa3) {
#define TRRD(dst, off) asm volatile("ds_read_b64_tr_b16 %0, %1 offset:%2" : "=&v"(dst) : "v"(vb0), "i"(off) : "memory")
#define PV_D0(d0) do { s16x4 l0, l1, l2, l3, h0, h1, h2, h3; constexpr int b_ = VB * SHM_V + v_rd_off(d0, 0, 0);   \
        TRRD(l0, b_); TRRD(h0, b_ + 2048); TRRD(l1, b_ + 4096); TRRD(h1, b_ + 6144); TRRD(l2, b_ + 8192); TRRD(h2, b_ + 10240); TRRD(l3, b_ + 12288); TRRD(h3, b_ + 14336); \
        asm volatile("s_waitcnt lgkmcnt(0)" ::: "memory"); SBAR();   \
        o[d0] = __builtin_amdgcn_mfma_f32_32x32x16_bf16(pa0, (bf16x8){l0[0], l0[1], l0[2], l0[3], h0[0], h0[1], h0[2], h0[3]}, o[d0], 0, 0, 0);   \
        o[d0] = __builtin_amdgcn_mfma_f32_32x32x16_bf16(pa1, (bf16x8){l1[0], l1[1], l1[2], l1[3], h1[0], h1[1], h1[2], h1[3]}, o[d0], 0, 0, 0);   \
        o[d0] = __builtin_amdgcn_mfma_f32_32x32x16_bf16(pa2, (bf16x8){l2[0], l2[1], l2[2], l2[3], h2[0], h2[1], h2[2], h2[3]}, o[d0], 0, 0, 0);   \
        o[d0] = __builtin_amdgcn_mfma_f32_32x32x16_bf16(pa3, (bf16x8){l3[0], l3[1], l3[2], l3[3], h3[0], h3[1], h3[2], h3[3]}, o[d0], 0, 0, 0); } while (0)
    PV_D0(0); PV_D0(1); PV_D0(2); PV_D0(3);
#undef PV_D0
#undef TRRD
}

struct BlockRef { const bf16_t* Q; const bf16_t* K; const bf16_t* V; bf16_t* O; const unsigned long long* RM; int P0; };
struct Seam { bf16x8 qr[8]; bf16x8 st_v0, st_v1, st_k0, st_k1; };
#define VMW() asm volatile("s_waitcnt vmcnt(0)" ::: "memory")
#define VMWN(n) asm volatile("s_waitcnt vmcnt(%0)" :: "i"(n) : "memory")
#define SLOAD_H(Kp, Vp, k0) do { const char* kt_ = (const char*)(Kp) + (size_t)(k0) * (LD * 2); const char* vt_ = (const char*)(Vp) + (size_t)(k0) * (LD * 2);              \
                         S.st_v0 = *(const bf16x8*)(vt_ + voff); S.st_v1 = *(const bf16x8*)(vt_ + 32 * LD * 2 + voff);              \
                         S.st_k0 = *(const bf16x8*)(kt_ + voff); S.st_k1 = *(const bf16x8*)(kt_ + 32 * LD * 2 + voff); } while (0)
#define SWRITE_HK(bf) do { *(bf16x8*)(K_lds + (bf) * SHM_K + kws) = S.st_k0; *(bf16x8*)(K_lds + (bf) * SHM_K + kws + 32 * 256) = S.st_k1; } while (0)
#define SWRITE_HV(bf) do { *(bf16x8*)(V_lds + (bf) * SHM_V + vst0) = S.st_v0; *(bf16x8*)(V_lds + (bf) * SHM_V + vst1) = S.st_v1; } while (0)
#define SWRITE_H(bf) do { SWRITE_HV(bf); SWRITE_HK(bf); } while (0)
template <int LD>
__device__ __forceinline__ void causal_prime(const BlockRef& cur, char* lds, Seam& S, const int tid) {
    const int wid = __builtin_amdgcn_readfirstlane(tid >> 6), lane = tid & 63, r32 = lane & 31, hi = lane >> 5;
    const int sr = tid >> 4, sc = (tid & 15) * 8, kws = KSWZ(sr, sc * 2); char* K_lds = lds + 2 * SHM_V;
    const unsigned voff = (unsigned)(sr * LD + sc) * 2u, qoff = (unsigned)(r32 * LD + hi * 8) * 2u;
    { const char* qb_ = (const char*)cur.Q + (size_t)(wid * QBLK) * (LD * 2);
      for (int d0 = 0; d0 < 8; ++d0) S.qr[d0] = *(const bf16x8*)(qb_ + qoff + d0 * 32); }
    SLOAD_H(cur.K, cur.V, 0); VMW(); SWRITE_HK(0);
    __syncthreads();
}
template <int LD, int LDO, bool MOBA>
__device__ __forceinline__ void causal_block(const BlockRef& cur, const BlockRef& nxt, char* lds, Seam& S, const int tid) {
    const int wid = __builtin_amdgcn_readfirstlane(tid >> 6), lane = tid & 63, r32 = lane & 31, hi = lane >> 5;
    constexpr int W = 1 << 30;
    const int NT = (cur.P0 + QB - 1) / KVBLK + 1;
    const int qlo = cur.P0 + wid * QBLK, qm = qlo + r32 - 4 * hi;
    char* V_lds = lds; char* K_lds = lds + 2 * SHM_V;
    float* ws = (float*)(lds + 2 * SHM_V + 2 * SHM_K) + wid * 64; float* li_l = ws, * al_l = ws + 32;
    float m_reg = -1e30f, l_reg = 0; f32x16 o[4] = {};
    const int sr = tid >> 4, sc = (tid & 15) * 8, vst0 = v_st(sr, sc), vst1 = v_st(32 + sr, sc), kws = KSWZ(sr, sc * 2);
    const unsigned voff = (unsigned)(sr * LD + sc) * 2u, qoff = (unsigned)(r32 * LD + hi * 8) * 2u;
    const int vb0 = (int)(uintptr_t)V_lds + v_rd_base(lane);
    const bf16_t* Kh = cur.K; const bf16_t* Vh = cur.V;
    unsigned* rm_l = (unsigned*)(lds + LDS_BYTES) + wid * 64;
    if constexpr (MOBA) { const unsigned long long rmask = cur.RM[(size_t)(wid * QBLK + r32) * 8]; if (hi == 0) { rm_l[2 * r32] = (unsigned)rmask; rm_l[2 * r32 + 1] = (unsigned)(rmask >> 32); } }
#define RESC(a) do { if (__any((a) < 1.f)) { if (hi == 0) al_l[r32] = (a); asm volatile("s_waitcnt lgkmcnt(0)" ::: "memory");              \
                     for (int d_ = 0; d_ < 4; ++d_) for (int r = 0; r < 16; ++r) o[d_][r] *= al_l[crow(r, hi)]; } } while (0)
#define KBASE(t) ((t) * KVBLK)
#define MASKT(P0_, P1_, t) do { const int kb_ = KBASE(t); if (kb_ + KVBLK - 1 > qlo || kb_ <= qlo + QBLK - 1 - W) mask_tile(P0_, P1_, qm - kb_, (unsigned)W); \
                                if constexpr (MOBA) { const int blk_ = kb_ >> 8; const unsigned mw_ = rm_l[2 * r32 + (blk_ >> 5)]; mask_all(P0_, P1_, ((mw_ >> (blk_ & 31)) & 1u) == 0u); } } while (0)
    constexpr int NQL = 8;
#define SEAM_K0() do { VMWN(NQL); SWRITE_HK(0); SBAR(); } while (0)
    f32x16 pA0, pA1, pB0, pB1; float mnA, mnB, alA, alB; bf16x8 pa0, pa1, pa2, pa3;
    SWRITE_HV(0); SBAR();
    if (NT > 1) { SLOAD_H(Kh, Vh, KBASE(1)); }
    SBAR(); qkt<0>(pA0, pA1, K_lds, r32, hi, S.qr);
    MASKT(pA0, pA1, 0); partialSM(pA0, pA1, m_reg, mnA, alA);
    if (NT > 1) { VMW(); SWRITE_H(1); }
    __syncthreads();
#define HALF_STEP(PX0, PX1, mnX, alX, PY0, PY1, alY, t, KB, VB, SB) do {                                                      \
        SBAR(); qkt<KB>(PX0, PX1, K_lds, r32, hi, S.qr);                                             \
        finishSM(PY0, PY1, alY, l_reg, pa0, pa1, pa2, pa3); SBAR();                                                           \
        if ((t) + 1 < NT) { SLOAD_H(Kh, Vh, KBASE((t) + 1)); SBAR(); }                                               \
        pv_tile<VB>(o, vb0, pa0, pa1, pa2, pa3); MASKT(PX0, PX1, (t)); partialSM(PX0, PX1, m_reg, mnX, alX);                                        \
        __syncthreads();                                                                                                      \
        if ((t) + 1 < NT) { VMW(); SWRITE_H(SB); }                                                                          \
        RESC(alX); __syncthreads(); } while (0)
    for (int t = 1; t + 1 < NT; t += 2) {
        HALF_STEP(pB0, pB1, mnB, alB, pA0, pA1, alA, t, 1, 0, 0);
        HALF_STEP(pA0, pA1, mnA, alA, pB0, pB1, alB, t + 1, 0, 1, 1);
    }
    const bool even = (NT & 1) == 0;
    if (even) { SBAR(); qkt<1>(pB0, pB1, K_lds, r32, hi, S.qr); SBAR(); }
    SLOAD_H(nxt.K, nxt.V, 0); SBAR();
    { const char* qb_ = (const char*)nxt.Q + (size_t)(wid * QBLK) * (LD * 2);
#pragma unroll
      for (int d0 = 0; d0 < 8; ++d0) S.qr[d0] = *(const bf16x8*)(qb_ + qoff + d0 * 32); }
    SBAR();
    finishSM(pA0, pA1, alA, l_reg, pa0, pa1, pa2, pa3); SBAR();
    pv_tile<0>(o, vb0, pa0, pa1, pa2, pa3);
    if (even) { MASKT(pB0, pB1, NT - 1); partialSM(pB0, pB1, m_reg, mnB, alB); __syncthreads(); RESC(alB);
        finishSM(pB0, pB1, alB, l_reg, pa0, pa1, pa2, pa3); SBAR(); pv_tile<1>(o, vb0, pa0, pa1, pa2, pa3); }
    SBAR(); SEAM_K0();
    if (hi == 0) li_l[r32] = l_reg; asm volatile("s_waitcnt lgkmcnt(0)" ::: "memory");
    float rli[16];
#pragma unroll
    for (int r = 0; r < 16; ++r) rli[r] = __builtin_amdgcn_rcpf(li_l[crow(r, hi)]);
    const char* ob_ = (const char*)cur.O + (size_t)(wid * QBLK) * (LDO * 2);
    int lane_e; asm volatile("v_mbcnt_lo_u32_b32 %0, -1, 0\n\tv_mbcnt_hi_u32_b32 %0, -1, %0" : "=v"(lane_e));
    const int r32e = lane_e & 31, hie = lane_e >> 5;
    const unsigned ooff = (unsigned)(4 * hie * LDO + r32e) * 2u;
#pragma unroll
    for (int r = 0; r < 16; ++r) { const char* orp_ = ob_ + (size_t)((r & 3) + 8 * (r >> 2)) * (LDO * 2);
#pragma unroll
        for (int d0 = 0; d0 < 4; ++d0) { const float v = o[d0][r] * rli[r];
            const float vn = __shfl_xor(v, 1);
            if ((r32e & 1) == 0) *(unsigned*)(orp_ + d0 * 64 + ooff) = cvtpk(v, vn); } }
    __syncthreads();
#undef RESC
#undef KBASE
#undef MASKT
#undef SEAM_K0
#undef HALF_STEP
}
#undef ROW
#undef VMW
#undef VMWN
#undef SLOAD_H
#undef SWRITE_HK
#undef SWRITE_HV
#undef SWRITE_H
#undef KSWZ
#undef SBAR
}
#define GAS __attribute__((address_space(1)))
#define LAS __attribute__((address_space(3)))
typedef unsigned short bf16;
typedef unsigned v4u __attribute__((ext_vector_type(4)));
typedef float f32x4 __attribute__((ext_vector_type(4)));
typedef short bf16x8 __attribute__((ext_vector_type(8)));
typedef GAS unsigned gu32;
typedef GAS unsigned long long gu64;
#define RLX_AGENT __ATOMIC_RELAXED, __HIP_MEMORY_SCOPE_AGENT
#define LDS_WAIT() asm volatile("s_waitcnt lgkmcnt(0)" ::: "memory")
#define VM_WAIT() asm volatile("s_waitcnt vmcnt(0)" ::: "memory")
__device__ __forceinline__ unsigned long long rt() { return __builtin_amdgcn_s_memrealtime(); }
__device__ __forceinline__ unsigned f2bf(float f) { unsigned u = __builtin_bit_cast(unsigned, f); return (u + 0x7fffu + ((u >> 16) & 1u)) >> 16; }
__device__ __forceinline__ unsigned pk2(float lo, float hi) { return f2bf(lo) | (f2bf(hi) << 16); }
#define XB_TMO      128
#define XB_XCNT(j)  (256  + 64 * (j))
#define XB_XSUB(j)  (1280 + 64 * (j))
#define XB_XGEN(j)  (2304 + 64 * (j))
#define XB_TOP      3328
#define XB_TOPGEN   3392
#define XCD_BAR_WORDS 3456
#define XB_SPIN_CAP (1u << 18)

__device__ __forceinline__ unsigned xb_ld(unsigned* p)              { return __hip_atomic_load(p, __ATOMIC_RELAXED, __HIP_MEMORY_SCOPE_AGENT); }
__device__ __forceinline__ unsigned xb_add(unsigned* p, unsigned v) { return __hip_atomic_fetch_add(p, v, __ATOMIC_RELAXED, __HIP_MEMORY_SCOPE_AGENT); }
__device__ __forceinline__ unsigned xb_xcc_id() { return (unsigned)__builtin_amdgcn_s_getreg((3 << 11) | 20) & 0xFu; }
#define XB_SPIN(cond, bar) do { unsigned _sp = 0; while (cond) { __builtin_amdgcn_s_sleep(1); \
    if ((++_sp & 255u) == 0u) { if (xb_ld(&(bar)[XB_TMO])) break; if (_sp > XB_SPIN_CAP) { atomicAdd(&(bar)[XB_TMO], 1u); break; } } } } while (0)

struct XcdBarrier {
    unsigned* bar; unsigned x;
    volatile LAS unsigned* st;
};

__device__ __forceinline__ XcdBarrier xcd_barrier_post(unsigned* bar, volatile LAS unsigned* st, const bool leader) {
    XcdBarrier b; b.bar = bar; b.x = xb_xcc_id(); b.st = st;
    if (leader) (void)xb_add(&bar[XB_XCNT(b.x)], 1u);
    return b;
}
__device__ __forceinline__ void xcd_barrier_complete(unsigned* bar, unsigned x, unsigned& nloc, unsigned& nx) {
    const unsigned G = gridDim.x * gridDim.y * gridDim.z;
    unsigned sum, cnt, mine, sp = 0u;
    for (;;) {
        sum = 0u; cnt = 0u; mine = 0u;
#pragma unroll
        for (unsigned j = 0; j < 16; ++j) { const unsigned c = xb_ld(&bar[XB_XCNT(j)]); sum += c; cnt += (c > 0u) ? 1u : 0u; mine = (j == x) ? c : mine; }
        if (sum == G) break;
        __builtin_amdgcn_s_sleep(1);
        if ((++sp & 255u) == 0u) { if (xb_ld(&bar[XB_TMO])) break; if (sp > XB_SPIN_CAP) { atomicAdd(&bar[XB_TMO], 1u); break; } }
    }
    nloc = mine > 0u ? mine : 1u; nx = cnt > 0u ? cnt : 1u;
}

__device__ __forceinline__ void xcd_barrier(const XcdBarrier& b, const bool leader) {
    asm volatile("s_waitcnt vmcnt(0)" ::: "memory");
    __syncthreads();
    if (leader) {
        unsigned* bar = b.bar;
        __builtin_amdgcn_s_waitcnt(0);
        unsigned nloc = b.st[0], nx = b.st[1];
        if (nloc == 0u) { xcd_barrier_complete(bar, b.x, nloc, nx); b.st[0] = nloc; b.st[1] = nx; }
        const unsigned old = xb_add(&bar[XB_XSUB(b.x)], 1u);
        const unsigned gen = old / nloc;
        if (old + 1u == (gen + 1u) * nloc) {
            __builtin_amdgcn_fence(__ATOMIC_RELEASE, "agent");
            asm volatile("s_waitcnt vmcnt(0)" ::: "memory");
            const unsigned og = xb_add(&bar[XB_TOP], 1u);
            const unsigned tg = og / nx;
            if (og + 1u == (tg + 1u) * nx) xb_add(&bar[XB_TOPGEN], 1u);
            else XB_SPIN(xb_ld(&bar[XB_TOPGEN]) == tg, bar);
            __builtin_amdgcn_fence(__ATOMIC_ACQUIRE, "agent");
            xb_add(&bar[XB_XGEN(b.x)], 1u);
            asm volatile("s_waitcnt vmcnt(0)" ::: "memory");
        } else {
            XB_SPIN(xb_ld(&bar[XB_XGEN(b.x)]) == gen, bar);
            __builtin_amdgcn_fence(__ATOMIC_ACQUIRE, "agent");
            asm volatile("s_waitcnt vmcnt(0)" ::: "memory");
        }
    }
    __syncthreads();
}

#ifndef NLAYERS_RUN
#define NLAYERS_RUN 4
#endif
constexpr int NWAVES = 8, NTHR = 512;
constexpr int BATCH = 2, SEQ = 16384, DM = 2048, DEPTH = 4;
constexpr int M = BATCH * SEQ;
constexpr int EV_IN = 6144, OD_IN = 2560, FFH = 5632, FF2 = 11264, NMOD = 12288;
constexpr float RMS_EPS = 1e-6f, SUBLN_EPS = 1e-5f;
#ifndef MK_PER_PHASE
#define MK_PER_PHASE 0
#endif

constexpr size_t MiB = 1u << 20;
constexpr size_t WS_CTL = 0, CTL_ZERO_BYTES = 1 * MiB;
constexpr size_t WS_MOD = 1 * MiB;
constexpr size_t WS_KM = 2 * MiB;
constexpr size_t WS_SEL = 3 * MiB;
constexpr size_t WS_ROPE = 5 * MiB;
constexpr size_t WS_W = 17 * MiB;
constexpr size_t W_EVIN = WS_W;
constexpr size_t W_EVOUT = W_EVIN + 48 * MiB;
constexpr size_t W_ODIN = W_EVOUT + 16 * MiB;
constexpr size_t W_ODOUT = W_ODIN + 20 * MiB;
constexpr size_t W_FFIN = W_ODOUT + 16 * MiB;
constexpr size_t W_FFOUT = W_FFIN + 176 * MiB;
constexpr size_t WS_HN = W_FFOUT + 88 * MiB;
constexpr size_t WS_PROJ = WS_HN + 128 * MiB;
constexpr size_t WS_OT = WS_PROJ + 384 * MiB;
constexpr size_t WS_Y = WS_OT + 128 * MiB;
constexpr size_t WS_END = WS_Y + 128 * MiB;
constexpr int CW_BAR = 4096;

constexpr int RING_OFF = 0, RING_BYTES = 131072;
constexpr int LDSCTL_OFF = RING_BYTES, MISC_OFF = LDSCTL_OFF + 320;
constexpr int LDS_BYTES = 147456;

struct Args {
    const float* x; const float* c; const float* ada_w; const float* ada_b; const float* ab_w_in; const float* ab_w_out; const float* diff_lambda; const float* diff_subln;
    const float* swa_w_in; const float* swa_b_in; const float* swa_w_out; const float* swa_b_out; const float* swa_sinks; const float* ffn_w_in; const float* ffn_w_out; const float* final_norm;
    float* out; unsigned char* ws;
    float invf128[64]; float invf64[32]; float lam_init[4];
    int ph_lo, ph_hi;
};
static_assert(sizeof(Args) % 8 == 0, "no tail padding");

__device__ __forceinline__ float wave_sum(float v) {
#pragma unroll
    for (int o = 1; o < 64; o <<= 1) v += __shfl_xor(v, o);
    return v;
}

template <int PERM_KIND>
__device__ __forceinline__ void p0_transpose_item(const float* W, int K, int N, bf16* WT, LAS float* scr, int item, int lane) {
    const int nblk = N / 32, kb = item / nblk, nb = item % nblk, k0 = 64 * kb, n0 = 32 * nb;
#pragma unroll 8
    for (int i = 0; i < 32; ++i) { const int kk = 2 * i + (lane >> 5); scr[kk * 33 + (lane & 31)] = W[(size_t)(k0 + kk) * N + n0 + (lane & 31)]; }
    LDS_WAIT(); asm volatile("" ::: "memory");
    const int c = lane & 7;
#pragma unroll
    for (int j = 0; j < 4; ++j) { const int n = (lane >> 3) + 8 * j; const LAS float* s = scr + (8 * c) * 33 + n;
        v4u o; o.x = pk2(s[0 * 33], s[1 * 33]); o.y = pk2(s[2 * 33], s[3 * 33]); o.z = pk2(s[4 * 33], s[5 * 33]); o.w = pk2(s[6 * 33], s[7 * 33]);
        const int nn = n0 + n;
        const int dst = PERM_KIND == 1 ? pg8::perm_even_in(nn) : PERM_KIND == 2 ? pg8::perm_odd_in(nn) : PERM_KIND == 3 ? pg8::perm_ffn_in(nn) : nn;
        *(GAS v4u*)(WT + (size_t)dst * K + k0 + 8 * c) = o; }
    LDS_WAIT(); asm volatile("" ::: "memory");
}
__device__ __forceinline__ void dsincos(double x, double& s, double& c) {
    const double k = __builtin_rint(x * 0.63661977236758134308);
    double r = __builtin_fma(-k, 1.57079632679489655800e+00, x); r = __builtin_fma(-k, 6.12323399573676603587e-17, r);
    const double z = r * r;
    double ps = -7.6471637318198164759e-13;
    ps = ps * z + 1.6059043836821614599e-10;
    ps = ps * z - 2.5052108385441718775e-08;
    ps = ps * z + 2.7557319223985890653e-06;
    ps = ps * z - 1.9841269841269841270e-04;
    ps = ps * z + 8.3333333333333333333e-03;
    ps = ps * z - 1.6666666666666666667e-01;
    const double sr = r + r * z * ps;
    double pc = 4.7794773323873852974e-14;
    pc = pc * z - 1.1470745597729724714e-11;
    pc = pc * z + 2.0876756987868098979e-09;
    pc = pc * z - 2.7557319223985890653e-07;
    pc = pc * z + 2.4801587301587301587e-05;
    pc = pc * z - 1.3888888888888888889e-03;
    pc = pc * z + 4.1666666666666666667e-02;
    pc = pc * z - 0.5;
    const double cr = 1.0 + z * pc;
    const int q = ((int)k) & 3;
    s = (q == 0) ? sr : (q == 1) ? cr : (q == 2) ? -sr : -cr;
    c = (q == 0) ? cr : (q == 1) ? -sr : (q == 2) ? -cr : sr;
}

__device__ __forceinline__ void norm_mod_phase(const float* xin, const float* sh0, const float* sc0, bf16* hn, int gw, int NGW, int lane) {
    for (int m = gw; m < M; m += NGW) {
        const GAS f32x4* xr = (const GAS f32x4*)(xin + (size_t)m * DM) + lane;
        const int bo = (m >= SEQ) ? NMOD : 0;
        const GAS f32x4* sc = (const GAS f32x4*)(sc0 + bo) + lane; const GAS f32x4* sh = (const GAS f32x4*)(sh0 + bo) + lane;
        f32x4 v[8]; float s = 0.f;
#pragma unroll
        for (int j = 0; j < 8; ++j) { v[j] = xr[64 * j]; s += (v[j].x * v[j].x + v[j].y * v[j].y) + (v[j].z * v[j].z + v[j].w * v[j].w); }
        const float rstd = 1.0f / sqrtf(wave_sum(s) * (1.f / DM) + RMS_EPS);
        GAS unsigned long long* o8 = (GAS unsigned long long*)(hn + (size_t)m * DM) + lane;
#pragma unroll
        for (int j = 0; j < 8; ++j) { const f32x4 a = sc[64 * j], b = sh[64 * j]; const f32x4 h = v[j] * rstd * (a + 1.0f) + b;
            o8[64 * j] = (unsigned long long)pk2(h.x, h.y) | ((unsigned long long)pk2(h.z, h.w) << 32); }
    }
}
__device__ __forceinline__ void final_norm_phase(float* x, const float* w, int gw, int NGW, int lane) {
    const GAS f32x4* wr = (const GAS f32x4*)w + lane;
    for (int m = gw; m < M; m += NGW) {
        GAS f32x4* xr = (GAS f32x4*)(x + (size_t)m * DM) + lane;
        f32x4 v[8]; float s = 0.f;
#pragma unroll
        for (int j = 0; j < 8; ++j) { v[j] = xr[64 * j]; s += (v[j].x * v[j].x + v[j].y * v[j].y) + (v[j].z * v[j].z + v[j].w * v[j].w); }
        const float rstd = 1.0f / sqrtf(wave_sum(s) * (1.f / DM) + RMS_EPS);
#pragma unroll
        for (int j = 0; j < 8; ++j) xr[64 * j] = v[j] * rstd * wr[64 * j];
    }
}
__device__ __forceinline__ void kmean_phase(const bf16* proj, float* km, LAS unsigned char* lds, int vcu, int G, int tid) {
    const int wave = tid >> 6, lane = tid & 63;
    LAS float* red = (LAS float*)lds;
    for (int u = vcu; u < BATCH * 64 * 2; u += G) {
        const int half = u & 1, j = (u >> 1) & 63, b = u >> 7;
        const bf16* src = proj + ((size_t)(b * SEQ + j * 256)) * EV_IN + 1024 + half * 512 + lane * 8;
        float a[8];
#pragma unroll
        for (int e = 0; e < 8; ++e) a[e] = 0.f;
        for (int r = wave; r < 256; r += 8) { const v4u w = *(const GAS v4u*)(src + (size_t)r * EV_IN);
            a[0] += __uint_as_float(w.x << 16); a[1] += __uint_as_float(w.x & 0xffff0000u); a[2] += __uint_as_float(w.y << 16); a[3] += __uint_as_float(w.y & 0xffff0000u);
            a[4] += __uint_as_float(w.z << 16); a[5] += __uint_as_float(w.z & 0xffff0000u); a[6] += __uint_as_float(w.w << 16); a[7] += __uint_as_float(w.w & 0xffff0000u); }
#pragma unroll
        for (int e = 0; e < 8; ++e) red[wave * 512 + lane * 8 + e] = a[e];
        __syncthreads();
        { const int col = tid; float s = 0.f;
#pragma unroll
          for (int w = 0; w < 8; ++w) s += red[w * 512 + col];
          const int cc = half * 512 + col, h = cc >> 7, d = cc & 127;
          km[(((size_t)(b * 8 + h)) * 64 + j) * 128 + d] = s * (1.0f / 256.0f); }
        __syncthreads();
    }
}
__device__ __forceinline__ void gate_phase(const bf16* proj, const float* km, unsigned long long* sel, LAS unsigned char* lds, int vcu, int G, int tid) {
    LAS float* kml = (LAS float*)lds;
    LAS float* mv = (LAS float*)(lds + 32768);
    LAS int* mi = (LAS int*)(lds + 32768 + 3072);
    for (int u = vcu; u < BATCH * 8 * 64; u += G) {
        const int i = u & 63, h = (u >> 6) & 7, b = u >> 9;
        const int qi = tid & 255, par = tid >> 8;
        const size_t row = (size_t)b * SEQ + i * 256 + qi;
        if (i == 0) { if (par == 0) sel[row * 8 + h] = 1ull; continue; }
        const float* kmsrc = km + ((size_t)(b * 8 + h) * 64) * 128;
        for (int e = tid; e < i * 128; e += NTHR) kml[e] = kmsrc[e];
        unsigned qw[64];
        { const GAS v4u* qp = (const GAS v4u*)(proj + row * EV_IN + h * 128);
#pragma unroll
          for (int e = 0; e < 16; ++e) { const v4u w = qp[e]; qw[4 * e] = w.x; qw[4 * e + 1] = w.y; qw[4 * e + 2] = w.z; qw[4 * e + 3] = w.w; } }
        __syncthreads();
        float v0 = -__builtin_inff(), v1 = v0, v2 = v0; int i0 = 64, i1 = 64, i2 = 64;
        for (int j = par; j < i; j += 2) {
            const LAS f32x4* kr = (const LAS f32x4*)(kml + j * 128);
            float g0 = 0.f, g1 = 0.f;
#pragma unroll
            for (int e = 0; e < 32; ++e) { const f32x4 k4 = kr[e];
                g0 = fmaf(__uint_as_float(qw[2 * e] << 16), k4.x, g0); g1 = fmaf(__uint_as_float(qw[2 * e] & 0xffff0000u), k4.y, g1);
                g0 = fmaf(__uint_as_float(qw[2 * e + 1] << 16), k4.z, g0); g1 = fmaf(__uint_as_float(qw[2 * e + 1] & 0xffff0000u), k4.w, g1); }
            const float g = g0 + g1;
            if (g > v0) { v2 = v1; i2 = i1; v1 = v0; i1 = i0; v0 = g; i0 = j; }
            else if (g > v1) { v2 = v1; i2 = i1; v1 = g; i1 = j; }
            else if (g > v2) { v2 = g; i2 = j; }
        }
        if (par == 1) { mv[qi * 3] = v0; mv[qi * 3 + 1] = v1; mv[qi * 3 + 2] = v2; mi[qi * 3] = i0; mi[qi * 3 + 1] = i1; mi[qi * 3 + 2] = i2; }
        __syncthreads();
        if (par == 0) {
            unsigned long long msk = 1ull << i;
            float av[3] = {v0, v1, v2}; int aidx[3] = {i0, i1, i2};
            float bv[3] = {mv[qi * 3], mv[qi * 3 + 1], mv[qi * 3 + 2]}; int bidx[3] = {mi[qi * 3], mi[qi * 3 + 1], mi[qi * 3 + 2]};
            int pa = 0, pb = 0;
#pragma unroll
            for (int t = 0; t < 3; ++t) {
                const float xa = pa == 0 ? av[0] : pa == 1 ? av[1] : pa == 2 ? av[2] : -__builtin_inff(); const int ia = pa == 0 ? aidx[0] : pa == 1 ? aidx[1] : pa == 2 ? aidx[2] : 64;
                const float xb = pb == 0 ? bv[0] : pb == 1 ? bv[1] : pb == 2 ? bv[2] : -__builtin_inff(); const int ib = pb == 0 ? bidx[0] : pb == 1 ? bidx[1] : pb == 2 ? bidx[2] : 64;
                const bool takea = (xa > xb) || (xa == xb && ia < ib);
                const int pick = takea ? ia : ib; if (takea) ++pa; else ++pb;
                if (pick < 64) msk |= 1ull << pick;
            }
            sel[row * 8 + h] = msk;
        }
        __syncthreads();
    }
}
__device__ __forceinline__ void diff_combine_phase(const bf16* ot, bf16* y, const float* lamv, const float* subln, float lam_init, int gw, int NGW, int lane) {
    float d1 = lamv[lane] * lamv[128 + lane] + lamv[64 + lane] * lamv[192 + lane];
    float d2 = lamv[256 + lane] * lamv[384 + lane] + lamv[320 + lane] * lamv[448 + lane];
    d1 = wave_sum(d1); d2 = wave_sum(d2);
    const float lam = expf(d1) - expf(d2) + lam_init;
    const f32x4 sw = *(const GAS f32x4*)(subln + 4 * lane);
    const float post = 1.0f - lam_init;
    for (int it = gw; it < M * 4; it += NGW) {
        const int hb = it & 3; const size_t row = (size_t)(it >> 2);
        const bf16* p = ot + row * DM + hb * 512 + 4 * lane;
        const unsigned long long w1 = *(const GAS unsigned long long*)p, w2 = *(const GAS unsigned long long*)(p + 256);
        f32x4 a, b;
        a.x = __uint_as_float((unsigned)w1 << 16); a.y = __uint_as_float((unsigned)w1 & 0xffff0000u); a.z = __uint_as_float((unsigned)(w1 >> 32) << 16); a.w = __uint_as_float((unsigned)(w1 >> 32) & 0xffff0000u);
        b.x = __uint_as_float((unsigned)w2 << 16); b.y = __uint_as_float((unsigned)w2 & 0xffff0000u); b.z = __uint_as_float((unsigned)(w2 >> 32) << 16); b.w = __uint_as_float((unsigned)(w2 >> 32) & 0xffff0000u);
        const f32x4 yb = a - b * lam;
        const float ss = wave_sum((yb.x * yb.x + yb.y * yb.y) + (yb.z * yb.z + yb.w * yb.w));
        const float rstd = 1.0f / sqrtf(ss * (1.0f / 256.0f) + SUBLN_EPS);
        const f32x4 o = yb * rstd * sw * post;
        *(GAS unsigned long long*)(y + row * DM + 1024 + hb * 256 + 4 * lane) = (unsigned long long)pk2(o.x, o.y) | ((unsigned long long)pk2(o.z, o.w) << 32);
    }
}

namespace swa {
typedef short bf16x8 __attribute__((ext_vector_type(8)));
typedef float f32x16 __attribute__((ext_vector_type(16)));
constexpr int KS_STRIDE = 144, VT_STRIDE = 528;
constexpr int OFF_K = 0, OFF_VT = 256 * KS_STRIDE, OFF_L = OFF_VT + 64 * VT_STRIDE, OFF_O = OFF_L + 8 * 32 * 4, O_STRIDE = 144, LDS_END = OFF_O + 8 * 32 * O_STRIDE;
static_assert(LDS_END <= RING_BYTES, "swa LDS");
__device__ __forceinline__ int crow(int r, int hi) { return (r & 3) + 8 * (r >> 2) + 4 * hi; }
__device__ __forceinline__ unsigned cvtpk(float lo, float hi) { unsigned r; asm volatile("v_cvt_pk_bf16_f32 %0, %1, %2" : "=v"(r) : "v"(lo), "v"(hi)); return r; }
__device__ __forceinline__ void phase(const bf16* proj, bf16* y, const float* sinks, LAS unsigned char* lds, int vcu, int G, int tid) {
    const int wave = __builtin_amdgcn_readfirstlane(tid >> 6), lane = tid & 63, r32 = lane & 31, hi = lane >> 5;
    constexpr float C2 = 0.125f * 1.4426950408889634f;
    for (int u = vcu; u < BATCH * 4 * 128; u += G) {
        const int bi = u & 127, kvh = (u >> 7) & 3, b = u >> 9;
#pragma unroll
        for (int i = 0; i < 4; ++i) { const int c = tid + NTHR * i, kk = c >> 3, ch = c & 7; const int kpos = (bi - 1) * 128 + kk;
            v4u kw = (v4u){0u, 0u, 0u, 0u}, vw = (v4u){0u, 0u, 0u, 0u};
            if (kpos >= 0) { const bf16* src = proj + ((size_t)b * SEQ + kpos) * OD_IN + 2048 + kvh * 64 + ch * 8; kw = *(const GAS v4u*)src; vw = *(const GAS v4u*)(src + 256); }
            *(LAS v4u*)(lds + OFF_K + kk * KS_STRIDE + ch * 16) = kw;
            LAS unsigned short* vt = (LAS unsigned short*)(lds + OFF_VT + (ch * 8) * VT_STRIDE + kk * 2);
            vt[0 * (VT_STRIDE / 2)] = (unsigned short)(vw.x & 0xffffu); vt[1 * (VT_STRIDE / 2)] = (unsigned short)(vw.x >> 16);
            vt[2 * (VT_STRIDE / 2)] = (unsigned short)(vw.y & 0xffffu); vt[3 * (VT_STRIDE / 2)] = (unsigned short)(vw.y >> 16);
            vt[4 * (VT_STRIDE / 2)] = (unsigned short)(vw.z & 0xffffu); vt[5 * (VT_STRIDE / 2)] = (unsigned short)(vw.z >> 16);
            vt[6 * (VT_STRIDE / 2)] = (unsigned short)(vw.w & 0xffffu); vt[7 * (VT_STRIDE / 2)] = (unsigned short)(vw.w >> 16); }
        __syncthreads();
        const int hq = kvh * 8 + wave;
        const float sinkl = sinks[hq] * 1.4426950408889634f;
        LAS float* Lw = (LAS float*)(lds + OFF_L) + wave * 32;
        LAS unsigned char* Ow = lds + OFF_O + wave * 32 * O_STRIDE;
        for (int sb = 0; sb < 4; ++sb) {
            const size_t qrow = (size_t)b * SEQ + bi * 128 + sb * 32;
            bf16x8 qr[4];
#pragma unroll
            for (int d0 = 0; d0 < 4; ++d0) qr[d0] = *(const GAS bf16x8*)(proj + (qrow + r32) * OD_IN + hq * 64 + d0 * 16 + hi * 8);
            const int t0 = sb >> 1;
            f32x16 p[3][2];
#pragma unroll
            for (int tt = 0; tt < 3; ++tt)
#pragma unroll
                for (int hf = 0; hf < 2; ++hf) { f32x16 a = {};
                    const LAS unsigned char* kb = lds + OFF_K + ((t0 + tt) * 64 + hf * 32 + r32) * KS_STRIDE + hi * 16;
#pragma unroll
                    for (int d0 = 0; d0 < 4; ++d0) { const bf16x8 kf = *(const LAS bf16x8*)(kb + d0 * 32); a = __builtin_amdgcn_mfma_f32_32x32x16_bf16(kf, qr[d0], a, 0, 0, 0); }
                    p[tt][hf] = a; }
            float mx = sinkl;
#pragma unroll
            for (int tt = 0; tt < 3; ++tt)
#pragma unroll
                for (int hf = 0; hf < 2; ++hf)
#pragma unroll
                    for (int r = 0; r < 16; ++r) { const int kk = (t0 + tt) * 64 + hf * 32 + crow(r, hi); const int rel = 128 + sb * 32 + r32 - kk;
                        const bool valid = (rel >= 0) && (rel < 128) && (bi > 0 || kk >= 128);
                        const float xv = valid ? p[tt][hf][r] * C2 : -__builtin_inff(); p[tt][hf][r] = xv; mx = fmaxf(mx, xv); }
            mx = fmaxf(mx, __shfl_xor(mx, 32));
            float ls = 0.f;
#pragma unroll
            for (int tt = 0; tt < 3; ++tt)
#pragma unroll
                for (int hf = 0; hf < 2; ++hf)
#pragma unroll
                    for (int r = 0; r < 16; ++r) { const float e = __builtin_amdgcn_exp2f(p[tt][hf][r] - mx); p[tt][hf][r] = e; ls += e; }
            ls += __shfl_xor(ls, 32);
            ls += __builtin_amdgcn_exp2f(sinkl - mx);
            f32x16 o[2] = {};
#pragma unroll
            for (int tt = 0; tt < 3; ++tt)
#pragma unroll
                for (int hf = 0; hf < 2; ++hf)
#pragma unroll
                    for (int s = 0; s < 2; ++s) { const f32x16& P = p[tt][hf]; const int B_ = 8 * s;
                        unsigned a0 = cvtpk(P[B_ + 0], P[B_ + 1]), a1 = cvtpk(P[B_ + 2], P[B_ + 3]), b0 = cvtpk(P[B_ + 4], P[B_ + 5]), b1 = cvtpk(P[B_ + 6], P[B_ + 7]);
                        auto r0 = __builtin_amdgcn_permlane32_swap(a0, b0, false, false); auto r1 = __builtin_amdgcn_permlane32_swap(a1, b1, false, false);
                        v4u w = {r0[0], r1[0], r0[1], r1[1]}; const bf16x8 pa = __builtin_bit_cast(bf16x8, w);
                        const int key0 = (t0 + tt) * 64 + hf * 32 + s * 16 + hi * 8;
#pragma unroll
                        for (int cb = 0; cb < 2; ++cb) { const bf16x8 vf = *(const LAS bf16x8*)(lds + OFF_VT + (cb * 32 + r32) * VT_STRIDE + key0 * 2);
                            o[cb] = __builtin_amdgcn_mfma_f32_32x32x16_bf16(pa, vf, o[cb], 0, 0, 0); } }
            if (hi == 0) Lw[r32] = ls;
            LDS_WAIT(); asm volatile("" ::: "memory");
#pragma unroll
            for (int r = 0; r < 16; ++r) { const float rl = __builtin_amdgcn_rcpf(Lw[crow(r, hi)]);
#pragma unroll
                for (int cb = 0; cb < 2; ++cb) *(LAS unsigned short*)(Ow + crow(r, hi) * O_STRIDE + (cb * 32 + r32) * 2) = (unsigned short)f2bf(o[cb][r] * rl); }
            LDS_WAIT(); asm volatile("" ::: "memory");
#pragma unroll
            for (int i = 0; i < 4; ++i) { const int c = lane + 64 * i, rr = c >> 3, ch = c & 7; const v4u w = *(const LAS v4u*)(Ow + rr * O_STRIDE + ch * 16);
                *(GAS v4u*)(y + (qrow + rr) * DM + hq * 64 + ch * 8) = w; }
            LDS_WAIT(); asm volatile("" ::: "memory");
        }
        __syncthreads();
    }
}
}

#ifndef NO_ATT
#define NO_ATT 0
#endif
#ifndef NO_SWA
#define NO_SWA 0
#endif
#ifndef NO_GATE
#define NO_GATE 0
#endif
#ifndef NO_GEMM
#define NO_GEMM 0
#endif
#ifndef NO_PRO
#define NO_PRO 0
#endif
#ifndef NO_MOBA
#define NO_MOBA 0
#endif
#ifndef NO_DIFF
#define NO_DIFF 0
#endif
struct Ctx {
    unsigned char* ws; int G, bx, vcu; int lo, hi; int wv;
};
__device__ __forceinline__ int fresh_tid_w(int wv) { int l; asm volatile("v_mbcnt_lo_u32_b32 %0, -1, 0\n\tv_mbcnt_hi_u32_b32 %0, -1, %0" : "=v"(l)); return wv * 64 + l; }
#define fresh_tid() fresh_tid_w(C.wv)
#if MK_PER_PHASE
#define IN_RANGE(k) (C.lo <= (k) && (k) < C.hi)
#define SEAM() do { ++ph; } while (0)
#else
#define IN_RANGE(k) (true)
#define SEAM() do { xcd_barrier(bar, fresh_tid() == 0); ++ph; } while (0)
#endif
typedef const __attribute__((address_space(4))) Args* ArgsP;
__device__ __forceinline__ ArgsP launder_args(ArgsP p) { asm volatile("" : "+s"(p)); return p; }
#define A_ (*launder_args(ap))
#define WSP(T, off) ((T*)(A_.ws + (off)))

template <int L>
__device__ __forceinline__ void layer_phases(ArgsP ap, const Ctx& C, const XcdBarrier& bar, int& ph, unsigned char* lds_raw) {
    LAS unsigned char* lds = (LAS unsigned char*)lds_raw;
    constexpr int li = L >> 1; constexpr bool even = (L & 1) == 0;
    const float* mod = WSP(const float, WS_MOD) + (size_t)L * 2 * NMOD;
    const float* xcur = (L == 0) ? A_.x : A_.out;
    if (IN_RANGE(ph)) { const int tid = fresh_tid(), lane = tid & 63, wave = __builtin_amdgcn_readfirstlane(tid >> 6); norm_mod_phase(xcur, mod + 0 * DM, mod + 1 * DM, WSP(bf16, WS_HN), C.vcu * NWAVES + wave, C.G * NWAVES, lane); }
    SEAM();
    if constexpr (even) {
        if (IN_RANGE(ph)) { if constexpr (!NO_GEMM) {
            pg8::Gemm g{WSP(const bf16, WS_HN), WSP(const bf16, W_EVIN) + (size_t)li * DM * EV_IN, M, EV_IN, DM}; pg8::StaticOrder S; S.init(M, EV_IN, C.G, C.bx);
            const float* cs = WSP(const float, WS_ROPE);
            pg8::EpiEvenIn E{WSP(bf16, WS_PROJ), cs, cs + SEQ * 64};
            pg8::gemm_phase<pg8::EpiEvenIn, pg8::StaticOrder, true, true>(lds + RING_OFF, g, S, E, C.wv); } }
        SEAM();
        if (IN_RANGE(ph)) kmean_phase(WSP(const bf16, WS_PROJ), WSP(float, WS_KM), lds, C.vcu, C.G, fresh_tid());
        SEAM();
        if (IN_RANGE(ph)) { if constexpr (!NO_GATE) gate_phase(WSP(const bf16, WS_PROJ), WSP(const float, WS_KM), WSP(unsigned long long, WS_SEL), lds, C.vcu, C.G, fresh_tid()); }
        SEAM();
        if (IN_RANGE(ph)) { if constexpr (!NO_ATT) {
            const int xcd = C.vcu >> 5, ci = C.vcu & 31;
            bf16* PROJ = WSP(bf16, WS_PROJ);
            if constexpr (!NO_MOBA) {
                att::Seam S; const int atid = fresh_tid();
                bf16* Y = WSP(bf16, WS_Y); const unsigned long long* SEL = WSP(const unsigned long long, WS_SEL);
                auto ref = [&](int n) { const int vh = 2 * xcd + (n >> 1), b = vh >> 3, h = vh & 7, qb = (n & 1) ? 63 - ci : ci; att::BlockRef r;
                    const size_t rq = (size_t)b * SEQ + qb * 256;
                    r.Q = PROJ + rq * EV_IN + h * 128; r.K = PROJ + (size_t)b * SEQ * EV_IN + 1024 + h * 128; r.V = PROJ + (size_t)b * SEQ * EV_IN + 2048 + h * 128;
                    r.O = Y + rq * DM + h * 128; r.RM = SEL + rq * 8 + h; r.P0 = qb * 256; return r; };
                att::BlockRef cur = ref(0); att::causal_prime<EV_IN>(cur, (char*)lds_raw, S, atid);
                for (int n = 0; n < 4; ++n) { const att::BlockRef nxt = (n + 1 < 4) ? ref(n + 1) : cur; att::causal_block<EV_IN, DM, true>(cur, nxt, (char*)lds_raw, S, atid); cur = nxt; }
            }
            if constexpr (!NO_DIFF) {
                att::Seam S; const int atid = fresh_tid();
                bf16* OT = WSP(bf16, WS_OT);
                auto ref = [&](int n) { const int vh = 4 * xcd + (n >> 1), b = vh >> 4, hb = (vh >> 2) & 3, mp = (vh >> 1) & 1, e = vh & 1, qb = (n & 1) ? 63 - ci : ci; att::BlockRef r;
                    const size_t rq = (size_t)b * SEQ + qb * 256;
                    r.Q = PROJ + rq * EV_IN + 3072 + (hb * 2 + mp) * 128; r.K = PROJ + (size_t)b * SEQ * EV_IN + 4096 + (hb * 2 + mp) * 128; r.V = PROJ + (size_t)b * SEQ * EV_IN + 5120 + hb * 256 + e * 128;
                    r.O = OT + rq * DM + hb * 512 + mp * 256 + e * 128; r.RM = nullptr; r.P0 = qb * 256; return r; };
                att::BlockRef cur = ref(0); att::causal_prime<EV_IN>(cur, (char*)lds_raw, S, atid);
                for (int n = 0; n < 8; ++n) { const att::BlockRef nxt = (n + 1 < 8) ? ref(n + 1) : cur; att::causal_block<EV_IN, DM, false>(cur, nxt, (char*)lds_raw, S, atid); cur = nxt; }
            }
        } }
        SEAM();
        if (IN_RANGE(ph)) { const int tid = fresh_tid(), lane = tid & 63, wave = __builtin_amdgcn_readfirstlane(tid >> 6);
            diff_combine_phase(WSP(const bf16, WS_OT), WSP(bf16, WS_Y), A_.diff_lambda + li * 512, A_.diff_subln + li * 256, A_.lam_init[L], C.vcu * NWAVES + wave, C.G * NWAVES, lane); }
        SEAM();
        if (IN_RANGE(ph)) { if constexpr (!NO_GEMM) {
            pg8::Gemm g{WSP(const bf16, WS_Y), WSP(const bf16, W_EVOUT) + (size_t)li * DM * DM, M, DM, DM}; pg8::StaticOrder S; S.init(M, DM, C.G, C.bx);
            pg8::EpiResid E{xcur, A_.out, mod + 2 * DM, nullptr};
            pg8::gemm_phase<pg8::EpiResid, pg8::StaticOrder, true, true>(lds + RING_OFF, g, S, E, C.wv); } }
        SEAM();
    } else {
        if (IN_RANGE(ph)) { if constexpr (!NO_GEMM) {
            pg8::Gemm g{WSP(const bf16, WS_HN), WSP(const bf16, W_ODIN) + (size_t)li * DM * OD_IN, M, OD_IN, DM}; pg8::StaticOrder S; S.init(M, OD_IN, C.G, C.bx);
            const float* cs = WSP(const float, WS_ROPE) + 2 * SEQ * 64;
            pg8::EpiOddIn E{WSP(bf16, WS_PROJ), cs, cs + SEQ * 32, A_.swa_b_in + li * OD_IN};
            pg8::gemm_phase<pg8::EpiOddIn, pg8::StaticOrder, true, true>(lds + RING_OFF, g, S, E, C.wv); } }
        SEAM();
        if (IN_RANGE(ph)) { if constexpr (!NO_SWA) swa::phase(WSP(const bf16, WS_PROJ), WSP(bf16, WS_Y), A_.swa_sinks + li * 32, lds, C.vcu, C.G, fresh_tid()); }
        SEAM();
        if (IN_RANGE(ph)) { if constexpr (!NO_GEMM) {
            pg8::Gemm g{WSP(const bf16, WS_Y), WSP(const bf16, W_ODOUT) + (size_t)li * DM * DM, M, DM, DM}; pg8::StaticOrder S; S.init(M, DM, C.G, C.bx);
            pg8::EpiResid E{xcur, A_.out, mod + 2 * DM, A_.swa_b_out + li * DM};
            pg8::gemm_phase<pg8::EpiResid, pg8::StaticOrder, true, true>(lds + RING_OFF, g, S, E, C.wv); } }
        SEAM();
    }
    if (IN_RANGE(ph)) { const int tid = fresh_tid(), lane = tid & 63, wave = __builtin_amdgcn_readfirstlane(tid >> 6); norm_mod_phase(A_.out, mod + 3 * DM, mod + 4 * DM, WSP(bf16, WS_HN), C.vcu * NWAVES + wave, C.G * NWAVES, lane); }
    SEAM();
    if (IN_RANGE(ph)) { if constexpr (!NO_GEMM) {
        pg8::Gemm g{WSP(const bf16, WS_HN), WSP(const bf16, W_FFIN) + (size_t)L * DM * FF2, M, FF2, DM}; pg8::StaticOrder S; S.init(M, FF2, C.G, C.bx);
        pg8::EpiFfnIn E{WSP(bf16, WS_PROJ)};
        pg8::gemm_phase<pg8::EpiFfnIn, pg8::StaticOrder, true, true>(lds + RING_OFF, g, S, E, C.wv); } }
    SEAM();
    if (IN_RANGE(ph)) { if constexpr (!NO_GEMM) {
        pg8::Gemm g{WSP(const bf16, WS_PROJ), WSP(const bf16, W_FFOUT) + (size_t)L * FFH * DM, M, DM, FFH}; pg8::StaticOrder S; S.init(M, DM, C.G, C.bx);
        pg8::EpiResid E{A_.out, A_.out, mod + 5 * DM, nullptr};
        pg8::gemm_phase<pg8::EpiResid, pg8::StaticOrder, true, true>(lds + RING_OFF, g, S, E, C.wv); } }
    SEAM();
}

__device__ __forceinline__ void prologue_phase(ArgsP ap, const Ctx& C, unsigned char* lds_raw) {
    const __attribute__((address_space(4))) Args& args = *launder_args(ap);
    LAS unsigned char* lds = (LAS unsigned char*)lds_raw;
    const int tid = fresh_tid(), lane = tid & 63, wave = __builtin_amdgcn_readfirstlane(tid >> 6);
    const int G = C.G, vcu = C.vcu, gw = vcu * NWAVES + wave, NGW = G * NWAVES;
    unsigned char* ws = args.ws;
    float* MOD = WSP(float, WS_MOD);
    float* COS128 = WSP(float, WS_ROPE); float* SIN128 = COS128 + SEQ * 64; float* COS64 = SIN128 + SEQ * 64; float* SIN64 = COS64 + SEQ * 32;
    LAS float* cond = (LAS float*)(lds + 73728);
    LAS float* red = (LAS float*)(lds + 90112);
    for (int e = tid; e < 2 * DM; e += NTHR) { const float cv = args.c[e]; cond[e] = cv / (1.0f + __expf(-cv)); }
    __syncthreads();
    for (int it = vcu; it < DEPTH * (NMOD / 64); it += G) {
        const int l = it / (NMOD / 64), ch = it % (NMOD / 64);
        const int cg = lane & 15, kr = lane >> 4;
        const float* wp = args.ada_w + (size_t)l * DM * NMOD + (size_t)(256 * wave + kr) * NMOD + ch * 64 + cg * 4;
        f32x4 a0 = {0.f, 0.f, 0.f, 0.f}, a1 = {0.f, 0.f, 0.f, 0.f};
#pragma unroll 8
        for (int i = 0; i < 64; ++i) { const f32x4 w = *(const GAS f32x4*)(wp + (size_t)(4 * i) * NMOD); const int k = 256 * wave + 4 * i + kr;
            a0 += w * cond[k]; a1 += w * cond[DM + k]; }
#pragma unroll
        for (int e = 0; e < 4; ++e) { a0[e] += __shfl_xor(a0[e], 16); a0[e] += __shfl_xor(a0[e], 32); a1[e] += __shfl_xor(a1[e], 16); a1[e] += __shfl_xor(a1[e], 32); }
        if (lane < 16) { *(LAS f32x4*)(red + (wave * 2 + 0) * 64 + cg * 4) = a0; *(LAS f32x4*)(red + (wave * 2 + 1) * 64 + cg * 4) = a1; }
        __syncthreads();
        if (tid < 128) { const int b = tid >> 6, col = tid & 63; float s = 0.f;
#pragma unroll
            for (int w = 0; w < 8; ++w) s += red[(w * 2 + b) * 64 + col];
            MOD[((size_t)l * 2 + b) * NMOD + ch * 64 + col] = s + args.ada_b[(size_t)l * NMOD + ch * 64 + col]; }
        __syncthreads();
    }
    for (int e = gw * 64 + lane; e < SEQ * 64; e += NGW * 64) { const int pos = e >> 6, i = e & 63; const float ang = (float)pos * args.invf128[i]; double s, c; dsincos((double)ang, s, c); COS128[e] = (float)c; SIN128[e] = (float)s; }
    for (int e = gw * 64 + lane; e < SEQ * 32; e += NGW * 64) { const int pos = e >> 5, i = e & 31; const float ang = (float)pos * args.invf64[i]; double s, c; dsincos((double)ang, s, c); COS64[e] = (float)c; SIN64[e] = (float)s; }
    LAS float* scr = (LAS float*)(lds + wave * 8704);
    for (int i = 0; i < 2; ++i) {
        { const int K = DM, N = EV_IN, NI = (K / 64) * (N / 32); const float* W = args.ab_w_in + (size_t)i * K * N; bf16* WT = (bf16*)(ws + W_EVIN) + (size_t)i * K * N;
          for (int it = gw; it < NI; it += NGW) p0_transpose_item<1>(W, K, N, WT, scr, it, lane); }
        { const int K = DM, N = DM, NI = (K / 64) * (N / 32); const float* W = args.ab_w_out + (size_t)i * K * N; bf16* WT = (bf16*)(ws + W_EVOUT) + (size_t)i * K * N;
          for (int it = gw; it < NI; it += NGW) p0_transpose_item<0>(W, K, N, WT, scr, it, lane); }
        { const int K = DM, N = OD_IN, NI = (K / 64) * (N / 32); const float* W = args.swa_w_in + (size_t)i * K * N; bf16* WT = (bf16*)(ws + W_ODIN) + (size_t)i * K * N;
          for (int it = gw; it < NI; it += NGW) p0_transpose_item<2>(W, K, N, WT, scr, it, lane); }
        { const int K = DM, N = DM, NI = (K / 64) * (N / 32); const float* W = args.swa_w_out + (size_t)i * K * N; bf16* WT = (bf16*)(ws + W_ODOUT) + (size_t)i * K * N;
          for (int it = gw; it < NI; it += NGW) p0_transpose_item<0>(W, K, N, WT, scr, it, lane); }
    }
    for (int l = 0; l < DEPTH; ++l) {
        { const int K = DM, N = FF2, NI = (K / 64) * (N / 32); const float* W = args.ffn_w_in + (size_t)l * K * N; bf16* WT = (bf16*)(ws + W_FFIN) + (size_t)l * K * N;
          for (int it = gw; it < NI; it += NGW) p0_transpose_item<3>(W, K, N, WT, scr, it, lane); }
        { const int K = FFH, N = DM, NI = (K / 64) * (N / 32); const float* W = args.ffn_w_out + (size_t)l * K * N; bf16* WT = (bf16*)(ws + W_FFOUT) + (size_t)l * K * N;
          for (int it = gw; it < NI; it += NGW) p0_transpose_item<0>(W, K, N, WT, scr, it, lane); }
    }
}

__global__ void __launch_bounds__(NTHR, 2) trunk_fwd(Args args) {
    extern __shared__ __attribute__((aligned(16))) unsigned char lds_raw[];
    LAS unsigned char* lds = (LAS unsigned char*)lds_raw;
    volatile LAS unsigned* MISC = (volatile LAS unsigned*)(lds + MISC_OFF);
    ArgsP ap = (ArgsP)__builtin_amdgcn_kernarg_segment_ptr();
    Ctx C; C.ws = nullptr; C.G = gridDim.x; C.bx = blockIdx.x; C.vcu = (C.G % 8 == 0) ? (C.bx % 8) * (C.G / 8) + C.bx / 8 : C.bx; C.lo = args.ph_lo; C.hi = args.ph_hi; C.wv = __builtin_amdgcn_readfirstlane(threadIdx.x >> 6);
    { const int tid = threadIdx.x; for (int u = tid; u < (LDS_BYTES - LDSCTL_OFF) / 4; u += NTHR) ((LAS unsigned*)(lds + LDSCTL_OFF))[u] = 0u; }
    __syncthreads();
#if MK_PER_PHASE
    XcdBarrier bar; bar.bar = nullptr; bar.x = 0; bar.st = nullptr;
#else
    XcdBarrier bar = xcd_barrier_post((unsigned*)(args.ws + WS_CTL) + CW_BAR, MISC + 8, threadIdx.x == 0);
#endif
    int ph = 0;
    if (IN_RANGE(ph)) { if constexpr (!NO_PRO) prologue_phase(ap, C, lds_raw); }
    SEAM();
    layer_phases<0>(ap, C, bar, ph, lds_raw);
#if NLAYERS_RUN > 1
    layer_phases<1>(ap, C, bar, ph, lds_raw);
    layer_phases<2>(ap, C, bar, ph, lds_raw);
    layer_phases<3>(ap, C, bar, ph, lds_raw);
#endif
    if (IN_RANGE(ph)) { const int tid = fresh_tid(), lane = tid & 63, wave = __builtin_amdgcn_readfirstlane(tid >> 6); final_norm_phase(A_.out, A_.final_norm, C.vcu * NWAVES + wave, C.G * NWAVES, lane); }
}
#undef IN_RANGE
#undef SEAM
#undef WSP
#undef A_
constexpr int N_PHASES = 1 + 2 * (7 + 3) + 2 * (4 + 3) + 1;

extern "C" void kernel_launch(void* const* d_in, const int* in_sizes, int n_in, void* d_out, int out_size, void* d_ws, size_t ws_size, hipStream_t stream) {
    static int grid = 0;
    if (grid == 0) {
        if (n_in != 16 || in_sizes[0] != M * DM || out_size != M * DM || ws_size < WS_END) { fprintf(stderr, "kernel_launch: unexpected shapes (n_in %d, in0 %d, out %d, ws %zu < %zu); nothing launched\n", n_in, n_in > 0 ? in_sizes[0] : -1, out_size, ws_size, (size_t)WS_END); grid = -1; return; }
        int dev = 0, cus = 0, per_cu = 0;
        if (hipGetDevice(&dev) != hipSuccess || hipDeviceGetAttribute(&cus, hipDeviceAttributeMultiprocessorCount, dev) != hipSuccess) { fprintf(stderr, "kernel_launch: device query failed\n"); grid = -1; return; }
        if (hipFuncSetAttribute((const void*)trunk_fwd, hipFuncAttributeMaxDynamicSharedMemorySize, LDS_BYTES) != hipSuccess) { fprintf(stderr, "kernel_launch: hipFuncSetAttribute failed\n"); grid = -1; return; }
        if (hipOccupancyMaxActiveBlocksPerMultiprocessor(&per_cu, (const void*)trunk_fwd, NTHR, LDS_BYTES) != hipSuccess || per_cu < 1) fprintf(stderr, "kernel_launch: note: occupancy query reports %d workgroups per CU\n", per_cu);
        (void)hipGetLastError();
        grid = cus;
        if (grid != 256) fprintf(stderr, "kernel_launch: built for 256 CUs, device has %d\n", grid);
    }
    if (grid < 0) return;
    if (hipMemsetAsync((char*)d_ws + WS_CTL, 0, CTL_ZERO_BYTES, stream) != hipSuccess) { fprintf(stderr, "kernel_launch: memset failed\n"); return; }
    Args a{};
    a.x = (const float*)d_in[0]; a.c = (const float*)d_in[1]; a.ada_w = (const float*)d_in[2]; a.ada_b = (const float*)d_in[3]; a.ab_w_in = (const float*)d_in[4]; a.ab_w_out = (const float*)d_in[5];
    a.diff_lambda = (const float*)d_in[6]; a.diff_subln = (const float*)d_in[7]; a.swa_w_in = (const float*)d_in[8]; a.swa_b_in = (const float*)d_in[9]; a.swa_w_out = (const float*)d_in[10];
    a.swa_b_out = (const float*)d_in[11]; a.swa_sinks = (const float*)d_in[12]; a.ffn_w_in = (const float*)d_in[13]; a.ffn_w_out = (const float*)d_in[14]; a.final_norm = (const float*)d_in[15];
    a.out = (float*)d_out; a.ws = (unsigned char*)d_ws;
    for (int i = 0; i < 64; ++i) a.invf128[i] = powf(10000.0f, -((float)(2 * i) / 128.0f));
    for (int i = 0; i < 32; ++i) a.invf64[i] = powf(10000.0f, -((float)(2 * i) / 64.0f));
    for (int l = 0; l < 4; ++l) a.lam_init[l] = (float)(0.8 - 0.6 * exp(-0.3 * (double)l));
#if MK_PER_PHASE
    for (int p = 0; p < N_PHASES; ++p) { a.ph_lo = p; a.ph_hi = p + 1; hipLaunchKernelGGL(trunk_fwd, dim3(grid), dim3(NTHR), LDS_BYTES, stream, a); }
#else
    a.ph_lo = 0; a.ph_hi = N_PHASES;
    hipLaunchKernelGGL(trunk_fwd, dim3(grid), dim3(NTHR), LDS_BYTES, stream, a);
#endif
    const hipError_t le = hipPeekAtLastError();
    if (le != hipSuccess) fprintf(stderr, "kernel_launch: launch failed: %s\n", hipGetErrorName(le));
}
```

```cpp
#include <hip/hip_runtime.h>
#include <cstdio>
#include <cstdint>
#include <cmath>

__device__ __forceinline__ float xl_xor(float v, int lane, int mask) { return __builtin_bit_cast(float, __builtin_amdgcn_ds_bpermute((lane ^ mask) << 2, __builtin_bit_cast(int, v))); }
__device__ __forceinline__ int xl_lane() { int l; asm volatile("v_mbcnt_lo_u32_b32 %0, -1, 0\n\tv_mbcnt_hi_u32_b32 %0, -1, %0" : "=v"(l)); return l; }
namespace pg8 {
#define PG8_LAS __attribute__((address_space(3)))
typedef unsigned short bf16_t;
typedef short bf16x8 __attribute__((ext_vector_type(8)));
typedef float f32x4 __attribute__((ext_vector_type(4)));
typedef unsigned u32x4 __attribute__((ext_vector_type(4)));
constexpr int BM = 256, BK = 64, HALF = 128, HTB = HALF * BK * 2  , STAGE_BYTES = 8 * HTB, NXCD = 8, WGM = 4;

__host__ __device__ __forceinline__ int lds_byte(int r, int c) { const int st = (r >> 4) * 2 + (c >> 5), rr = r & 15, cc = c & 31, ob = rr * 64 + cc * 2; return st * 1024 + (ob ^ (((ob >> 9) & 1) << 5)); }
__host__ __device__ __forceinline__ void stage_rc(int b, int& R, int& C) { const int st = b / 1024, sb = b % 1024, swz = sb ^ (((sb >> 9) & 1) << 5); R = (st >> 1) * 16 + swz / 64; C = (st & 1) * 32 + (swz % 64) / 2; }
__host__ __device__ __forceinline__ int perm32(int rho) { const int n = rho >> 4, i = rho & 15; return 8 * (i >> 2) + 4 * n + (i & 3); }

struct Unit { int pm, pn; };
struct Gemm { const bf16_t* A; const bf16_t* Bt; int M, N, K; };

struct StaticOrder {
    int nM, nN, nwg, G, c;
    __host__ __device__ void init(int M, int N, int G_, int c_) { nM = M / BM; nN = N / BM; nwg = nM * nN; G = G_; c = c_; }
    __host__ __device__ bool next(int i, Unit& u) const {
        const long L = (long)i * G + c; if (L >= nwg) return false;
        int wgid = (int)L; { const int q = nwg / NXCD, r = nwg % NXCD, xcd = wgid % NXCD, off = wgid / NXCD; wgid = (xcd < r ? xcd * (q + 1) : r * (q + 1) + (xcd - r) * q) + off; }
        const int nig = WGM * nN, gid = wgid / nig, fm = gid * WGM, gsz = (nM - fm) < WGM ? (nM - fm) : WGM;
        u.pm = fm + ((wgid % nig) % gsz); u.pn = (wgid % nig) / gsz; return true;
    }
    __device__ __forceinline__ void a_ready(const Unit&) const {}
    __device__ __forceinline__ void done(const Unit&) const {}
};
struct FfnInOrder { int c;
    __host__ __device__ bool next(int i, Unit& u) const { if (i >= 22) return false; const int xcd = c & 7, j = c >> 3, p = i / 11, r = i - p * 11;
        if (r < 10) { const int g = 2 * p + (r >= 5 ? 1 : 0), cb = r >= 5 ? r - 5 : r; u.pm = xcd * 16 + 4 * g + (j & 3); u.pn = 8 * cb + (j >> 2); }
        else { u.pm = xcd * 16 + 8 * p + (j & 7); u.pn = 40 + (j >> 3); }
        return true; }
    __device__ __forceinline__ void a_ready(const Unit&) const {}
    __device__ __forceinline__ void done(const Unit&) const {}
};
struct OddInOrder { int c;
    __host__ __device__ bool next(int i, Unit& u) const { if (i >= 5) return false; const int xcd = c & 7, j = c >> 3;
        if (i < 4) { u.pm = xcd * 16 + 4 * i + (j & 3); u.pn = j >> 2; } else { u.pm = xcd * 16 + (j & 15); u.pn = 8 + (j >> 4); }
        return true; }
    __device__ __forceinline__ void a_ready(const Unit&) const {}
    __device__ __forceinline__ void done(const Unit&) const {}
};


__device__ __forceinline__ unsigned cvt_pk_bf16(float lo, float hi) { unsigned r; asm volatile("v_cvt_pk_bf16_f32 %0, %1, %2" : "=v"(r) : "v"(lo), "v"(hi)); return r; }
typedef float f32x2 __attribute__((ext_vector_type(2)));
typedef unsigned u32x2 __attribute__((ext_vector_type(2)));
constexpr int SEQ_LEN = 16384;
typedef _Float16 f16x8 __attribute__((ext_vector_type(8)));
typedef _Float16 f16x4 __attribute__((ext_vector_type(4)));
template <bool F16> __device__ __forceinline__ f32x4 mma16(bf16x8 a, bf16x8 b, f32x4 c) {
    if constexpr (F16) return __builtin_amdgcn_mfma_f32_16x16x32_f16(__builtin_bit_cast(f16x8, a), __builtin_bit_cast(f16x8, b), c, 0, 0, 0);
    else return __builtin_amdgcn_mfma_f32_16x16x32_bf16(a, b, c, 0, 0, 0);
}
__device__ __forceinline__ u32x2 pack4h(f32x4 v) { f16x4 h = {(_Float16)v[0], (_Float16)v[1], (_Float16)v[2], (_Float16)v[3]}; return __builtin_bit_cast(u32x2, h); }
#ifndef MK_XA_F16
#define MK_XA_F16 0
#endif
constexpr bool XA_F16 = MK_XA_F16 != 0;
constexpr int BIAS_BSTRIDE = 11264;
constexpr float NORM_EPS = 1e-6f, INV_DM = 1.0f / 2048.0f;
constexpr int SS_PSTRIDE = 2 * 16384;
__device__ __forceinline__ void load_rstd(float (&rs)[2][4], const float* ss, int row0) {
#pragma unroll
    for (int ai = 0; ai < 2; ++ai)
#pragma unroll
        for (int m = 0; m < 4; ++m) rs[ai][m] = __builtin_amdgcn_rsqf(ss[row0 + ai * HALF + m * 16] * INV_DM + NORM_EPS);
}

__host__ __device__ __forceinline__ int rope128_slot(int d) { return d; }
__host__ __device__ __forceinline__ int rope64_slot(int d) { return 8 * ((d & 31) >> 2) + 4 * (d >> 5) + (d & 3); }
__host__ __device__ __forceinline__ int perm_even_in(int c) { const int region = c >> 10; if (region == 2 || region == 5) return c; const int hh = (c >> 7) & 1, d = c & 127;
    return (c & ~255) + 128 * (d >> 6) + 32 * (2 * hh + ((d >> 5) & 1)) + (d & 31); }
__host__ __device__ __forceinline__ int perm_odd_in(int c) { if (c >= 2304) return c; const int hh = (c >> 6) & 3, d = c & 63; return (c & ~255) + 128 * (d >> 5) + 32 * hh + (d & 31); }
__host__ __device__ __forceinline__ int perm_ffn_in(int c) { const int up = c >= 5632 ? 1 : 0; const int j = c - up * 5632; return 256 * (j >> 7) + 128 * up + (j & 127); }

__device__ __forceinline__ u32x2 pack4(f32x4 v) { u32x2 w; w.x = cvt_pk_bf16(v[0], v[1]); w.y = cvt_pk_bf16(v[2], v[3]); return w; }


template <int TROW, int OSTR, int W2B>
__device__ __forceinline__ void rope_rows(const f32x4 (&acc)[2][2][4][2], const float (&rs)[2][4], const PG8_LAS float* pfb, const char* tu, unsigned vt, char* ou, unsigned vs) {
    u32x4 tc0[2], ts0[2], tc1[2], ts1[2];
#define RP_LOAD(TC, TS, it) do { _Pragma("unroll") for (int mm = 0; mm < 2; ++mm) { const char* p_ = tu + (size_t)(((it) >> 1) * HALF + (((it) & 1) * 2 + mm) * 16) * TROW; \
            TC[mm] = *(const u32x4*)(p_ + vt); TS[mm] = *(const u32x4*)(p_ + 256 + vt); } asm volatile("" ::: "memory"); } while (0)
#define RP_PIN(TC, TS) asm volatile("" : "+v"(TC[0]), "+v"(TC[1]), "+v"(TS[0]), "+v"(TS[1]) :: "memory")
#define RP_BODY(TC, TS, it) do { const int ai = (it) >> 1; _Pragma("unroll") for (int mm = 0; mm < 2; ++mm) { const int m = ((it) & 1) * 2 + mm; \
            const f16x8 ch = __builtin_bit_cast(f16x8, TC[mm]), sh = __builtin_bit_cast(f16x8, TS[mm]); u32x4 w1, w2; \
            _Pragma("unroll") for (int n = 0; n < 2; ++n) { \
                const f32x4 cv = {(float)ch[4 * n], (float)ch[4 * n + 1], (float)ch[4 * n + 2], (float)ch[4 * n + 3]}, sv = {(float)sh[4 * n], (float)sh[4 * n + 1], (float)sh[4 * n + 2], (float)sh[4 * n + 3]}; \
                const f32x4 x1 = acc[ai][0][m][n] * rs[ai][m] + *(const PG8_LAS f32x4*)(pfb + 4 * n), x2 = acc[ai][1][m][n] * rs[ai][m] + *(const PG8_LAS f32x4*)(pfb + HALF + 4 * n); \
                const u32x2 a = pack4(x1 * cv - x2 * sv), b = pack4(x2 * cv + x1 * sv); \
                if (n == 0) { w1.x = a.x; w1.y = a.y; w2.x = b.x; w2.y = b.y; } else { w1.z = a.x; w1.w = a.y; w2.z = b.x; w2.w = b.y; } } \
            char* p = ou + (size_t)(ai * HALF + m * 16) * OSTR * 2; *(u32x4*)(p + vs) = w1; *(u32x4*)(p + W2B + vs) = w2; } \
        asm volatile("" ::: "memory"); } while (0)
    RP_LOAD(tc0, ts0, 0);
    RP_LOAD(tc1, ts1, 1); asm volatile("s_waitcnt vmcnt(4)" ::: "memory"); RP_PIN(tc0, ts0); RP_BODY(tc0, ts0, 0);
    RP_LOAD(tc0, ts0, 2); asm volatile("s_waitcnt vmcnt(8)" ::: "memory"); RP_PIN(tc1, ts1); RP_BODY(tc1, ts1, 1);
    RP_LOAD(tc1, ts1, 3); asm volatile("s_waitcnt vmcnt(8)" ::: "memory"); RP_PIN(tc0, ts0); RP_BODY(tc0, ts0, 2);
    asm volatile("s_waitcnt vmcnt(4)" ::: "memory"); RP_PIN(tc1, ts1); RP_BODY(tc1, ts1, 3);
#undef RP_LOAD
#undef RP_PIN
#undef RP_BODY
}
struct EpiEvenIn {
    static constexpr bool PERM = true, AFTER_DRAIN = false, F16 = XA_F16;
    bf16_t* O; const _Float16* tab; const float* ss; const float* bias0; PG8_LAS float* pf;
    __device__ __forceinline__ float prefetch(const Unit& u, int tid) const { if (tid < 256) { const float* p = ss + u.pm * BM + tid; float a = p[0];
#pragma unroll
            for (int j = 1; j < 8; ++j) a += p[(size_t)j * SS_PSTRIDE]; return a; }
        return bias0[(u.pm >= (SEQ_LEN / BM) ? BIAS_BSTRIDE : 0) + u.pn * BM + (tid - 256)]; }
    __device__ __forceinline__ void operator()(const f32x4 (&acc)[2][2][4][2], const Unit& u, int wr, int wc, int fr_, int fq_, float epre) const {
        int lane_; asm volatile("v_mbcnt_lo_u32_b32 %0, -1, 0\n\tv_mbcnt_hi_u32_b32 %0, -1, %0" : "=v"(lane_)); const int fr = lane_ & 15, fq = lane_ >> 4; (void)fr_; (void)fq_;
        const int row0 = u.pm * BM + wr * 64 + fr; const int region = u.pn >> 2;
        pf[(wr * 4 + wc) * 64 + lane_] = epre;
        asm volatile("s_waitcnt lgkmcnt(0)" ::: "memory"); __builtin_amdgcn_s_barrier(); asm volatile("" ::: "memory");
        float rs[2][4];
#pragma unroll
        for (int ai = 0; ai < 2; ++ai)
#pragma unroll
            for (int m = 0; m < 4; ++m) rs[ai][m] = __builtin_amdgcn_rsqf(pf[ai * HALF + wr * 64 + m * 16 + fr] * INV_DM + NORM_EPS);
        f32x4 bb[2][2];
#pragma unroll
        for (int bj = 0; bj < 2; ++bj)
#pragma unroll
            for (int n = 0; n < 2; ++n) bb[bj][n] = *(const PG8_LAS f32x4*)(pf + 256 + bj * HALF + wc * 32 + 8 * fq + 4 * n);
        if (region != 2 && region != 5) {
            const char* tu = (const char*)tab + (size_t)((u.pm & (SEQ_LEN / BM - 1)) * BM + wr * 64) * 256 + (wc & 1) * 2048;
            char* ou = (char*)O + ((size_t)(u.pm * BM + wr * 64) * 6144 + u.pn * BM + (wc >> 1) * HALF + 32 * (wc & 1)) * 2;
            rope_rows<256, 6144, 128>(acc, rs, pf + 256 + wc * 32 + 8 * fq, tu, (unsigned)(fq * 512 + fr * 16), ou, (unsigned)(fr * 6144 + 8 * fq) * 2u);
        } else {
            const int col0 = u.pn * BM + wc * 32 + 8 * fq;
#pragma unroll
            for (int ai = 0; ai < 2; ++ai)
#pragma unroll
                for (int m = 0; m < 4; ++m) { bf16_t* rowp = O + (size_t)(row0 + ai * HALF + m * 16) * 6144 + col0;
#pragma unroll
                    for (int bj = 0; bj < 2; ++bj) { const f32x4 v0 = acc[ai][bj][m][0] * rs[ai][m] + bb[bj][0], v1 = acc[ai][bj][m][1] * rs[ai][m] + bb[bj][1];
                        u32x4 w; w.x = cvt_pk_bf16(v0[0], v0[1]); w.y = cvt_pk_bf16(v0[2], v0[3]); w.z = cvt_pk_bf16(v1[0], v1[1]); w.w = cvt_pk_bf16(v1[2], v1[3]);
                        *(u32x4*)(rowp + bj * HALF) = w; } }
        }
    }
};
struct EpiOddIn {
    static constexpr bool PERM = true, AFTER_DRAIN = false, F16 = XA_F16;
    bf16_t* O; const _Float16* tab; const float* ss; const float* bias0; PG8_LAS float* pf;
    __device__ __forceinline__ float prefetch(const Unit& u, int tid) const { if (tid < 256) { const float* p = ss + u.pm * BM + tid; float a = p[0];
#pragma unroll
            for (int j = 1; j < 8; ++j) a += p[(size_t)j * SS_PSTRIDE]; return a; }
        return bias0[(u.pm >= (SEQ_LEN / BM) ? BIAS_BSTRIDE : 0) + u.pn * BM + (tid - 256)]; }
    __device__ __forceinline__ void operator()(const f32x4 (&acc)[2][2][4][2], const Unit& u, int wr, int wc, int fr_, int fq_, float epre) const {
        int lane_; asm volatile("v_mbcnt_lo_u32_b32 %0, -1, 0\n\tv_mbcnt_hi_u32_b32 %0, -1, %0" : "=v"(lane_)); const int fr = lane_ & 15, fq = lane_ >> 4; (void)fr_; (void)fq_;
        const int row0 = u.pm * BM + wr * 64 + fr;
        pf[(wr * 4 + wc) * 64 + lane_] = epre;
        asm volatile("s_waitcnt lgkmcnt(0)" ::: "memory"); __builtin_amdgcn_s_barrier(); asm volatile("" ::: "memory");
        float rs[2][4];
#pragma unroll
        for (int ai = 0; ai < 2; ++ai)
#pragma unroll
            for (int m = 0; m < 4; ++m) rs[ai][m] = __builtin_amdgcn_rsqf(pf[ai * HALF + wr * 64 + m * 16 + fr] * INV_DM + NORM_EPS);
        f32x4 bb[2][2];
#pragma unroll
        for (int bj = 0; bj < 2; ++bj)
#pragma unroll
            for (int n = 0; n < 2; ++n) bb[bj][n] = *(const PG8_LAS f32x4*)(pf + 256 + bj * HALF + wc * 32 + 8 * fq + 4 * n);
        if (u.pn < 9) {
            const char* tu = (const char*)tab + (size_t)((u.pm & (SEQ_LEN / BM - 1)) * BM + wr * 64) * 128;
            char* ou = (char*)O + ((size_t)(u.pm * BM + wr * 64) * 2560 + u.pn * BM + wc * 64) * 2;
            rope_rows<128, 2560, 64>(acc, rs, pf + 256 + wc * 32 + 8 * fq, tu, (unsigned)(fq * 512 + fr * 16), ou, (unsigned)(fr * 2560 + 8 * fq) * 2u);
        } else {
            const int col0 = u.pn * BM + wc * 32 + 8 * fq;
#pragma unroll
            for (int ai = 0; ai < 2; ++ai)
#pragma unroll
                for (int m = 0; m < 4; ++m) { bf16_t* rowp = O + (size_t)(row0 + ai * HALF + m * 16) * 2560 + col0;
#pragma unroll
                    for (int bj = 0; bj < 2; ++bj) { const f32x4 v0 = acc[ai][bj][m][0] * rs[ai][m] + bb[bj][0], v1 = acc[ai][bj][m][1] * rs[ai][m] + bb[bj][1];
                        u32x4 w; w.x = cvt_pk_bf16(v0[0], v0[1]); w.y = cvt_pk_bf16(v0[2], v0[3]); w.z = cvt_pk_bf16(v1[0], v1[1]); w.w = cvt_pk_bf16(v1[2], v1[3]);
                        *(u32x4*)(rowp + bj * HALF) = w; } }
        }
    }
};
struct EpiFfnIn {
    static constexpr bool PERM = true, AFTER_DRAIN = false, F16 = XA_F16;
    bf16_t* O; const float* ss; const float* bias0; PG8_LAS float* pf;
    __device__ __forceinline__ float prefetch(const Unit& u, int tid) const { if (tid < 256) { const float* p = ss + u.pm * BM + tid; float a = p[0];
#pragma unroll
            for (int j = 1; j < 8; ++j) a += p[(size_t)j * SS_PSTRIDE]; return a; }
        return bias0[(u.pm >= (SEQ_LEN / BM) ? BIAS_BSTRIDE : 0) + u.pn * BM + (tid - 256)]; }
    __device__ __forceinline__ void operator()(const f32x4 (&acc)[2][2][4][2], const Unit& u, int wr, int wc, int fr_, int fq_, float epre) const {
        int lane_; asm volatile("v_mbcnt_lo_u32_b32 %0, -1, 0\n\tv_mbcnt_hi_u32_b32 %0, -1, %0" : "=v"(lane_)); const int fr = lane_ & 15, fq = lane_ >> 4; (void)fr_; (void)fq_;
        const int row0 = u.pm * BM + wr * 64 + fr; const int col0 = u.pn * HALF + 32 * wc + 8 * fq;
        pf[(wr * 4 + wc) * 64 + lane_] = epre;
        asm volatile("s_waitcnt lgkmcnt(0)" ::: "memory"); __builtin_amdgcn_s_barrier(); asm volatile("" ::: "memory");
        float rs[2][4];
#pragma unroll
        for (int ai = 0; ai < 2; ++ai)
#pragma unroll
            for (int m = 0; m < 4; ++m) rs[ai][m] = __builtin_amdgcn_rsqf(pf[ai * HALF + wr * 64 + m * 16 + fr] * INV_DM + NORM_EPS);
        f32x4 bb[2][2];
#pragma unroll
        for (int bj = 0; bj < 2; ++bj)
#pragma unroll
            for (int n = 0; n < 2; ++n) bb[bj][n] = *(const PG8_LAS f32x4*)(pf + 256 + bj * HALF + wc * 32 + 8 * fq + 4 * n);
#pragma unroll
        for (int ai = 0; ai < 2; ++ai)
#pragma unroll
            for (int m = 0; m < 4; ++m) { bf16_t* rowp = O + (size_t)(row0 + ai * HALF + m * 16) * 5632 + col0; u32x4 w;
#pragma unroll
                for (int n = 0; n < 2; ++n) { const f32x4 g = acc[ai][0][m][n] * rs[ai][m] + bb[0][n], up = acc[ai][1][m][n] * rs[ai][m] + bb[1][n]; f32x4 h;
#pragma unroll
                    for (int i = 0; i < 4; ++i) { const float ex = __builtin_amdgcn_exp2f(g[i] * -1.4426950408889634f); h[i] = g[i] * __builtin_amdgcn_rcpf(1.0f + ex) * up[i]; }
                    const u32x2 pk = pack4(h); if (n == 0) { w.x = pk.x; w.y = pk.y; } else { w.z = pk.x; w.w = pk.y; } }
                *(u32x4*)rowp = w; }
    }
};
__device__ __forceinline__ int quad_tr_src(int lane) { return ((lane & 0x0c) | ((lane & 3) << 4) | ((lane >> 4) & 3)) << 2; }
__device__ __forceinline__ u32x4 quad_tr(u32x4 w, int srcb) { u32x4 r; r.x = (unsigned)__builtin_amdgcn_ds_bpermute(srcb, (int)w.x); r.y = (unsigned)__builtin_amdgcn_ds_bpermute(srcb, (int)w.y);
    r.z = (unsigned)__builtin_amdgcn_ds_bpermute(srcb, (int)w.z); r.w = (unsigned)__builtin_amdgcn_ds_bpermute(srcb, (int)w.w); return r; }
__device__ __forceinline__ f32x4 sigma4(f32x4 sc) { f32x4 r;
#pragma unroll
    for (int i = 0; i < 4; ++i) { const float v = 1.0f + sc[i]; r[i] = __builtin_fabsf(v) < 1e-20f ? __builtin_copysignf(1e-20f, v) : v; }
    return r; }
template <bool BASEF32, bool HAS_NEXT> struct EpiResidH {
    static constexpr bool PERM = true, AFTER_DRAIN = false, F16 = false;
    const void* base; bf16_t* xa; bf16_t* xfin; const float* gate0; const float* bias; const float* scp0; const float* scn0; float* ssn; PG8_LAS float* red;
    __device__ __forceinline__ float prefetch(const Unit&, int) const { return 0.f; }
    __device__ __forceinline__ void operator()(const f32x4 (&acc)[2][2][4][2], const Unit& u, int wr, int wc, int fr_, int fq_, float) const {
        int lane_; asm volatile("v_mbcnt_lo_u32_b32 %0, -1, 0\n\tv_mbcnt_hi_u32_b32 %0, -1, %0" : "=v"(lane_));
        const int fr = lane_ & 15, fq = lane_ >> 4; (void)fr_; (void)fq_;
        const int bo = u.pm >= (SEQ_LEN / BM) ? 12288 : 0;
        float s2a[2][4];
#pragma unroll
        for (int ai = 0; ai < 2; ++ai)
#pragma unroll
            for (int m = 0; m < 4; ++m) s2a[ai][m] = 0.f;
        constexpr int NR = 2;
        constexpr int NLD = 2, NST = 2;
        const size_t uoff = (size_t)(u.pm * BM + wr * 64) * 2048 + u.pn * BM + wc * 32;
        const unsigned vo2 = (unsigned)(fr * 2048 + 8 * fq) * 2u, vo4 = vo2 * 2u, vv = (unsigned)fq * 32u;
        const unsigned vo2n = (unsigned)(((fr & 12) | fq) * 2048 + 8 * (fr & 3)) * 2u;
        const int srcb = quad_tr_src(lane_);
        const char* b_u = (const char*)base + uoff * (BASEF32 ? 4 : 2); const char* xa_u = (const char*)xa + uoff * 2; const char* xf_u = (const char*)xfin + uoff * 2;
        const char* g_u = (const char*)(gate0 + bo + u.pn * BM + wc * 32); const char* bi_u = (const char*)(bias + u.pn * BM + wc * 32);
        const char* sp_u = (const char*)(scp0 + bo + u.pn * BM + wc * 32); const char* sc_u = (const char*)(scn0 + bo + u.pn * BM + wc * 32);
        u32x4 hb0[2], hb1[2]; f32x4 fb0[2][2], fb1[2][2];
        f32x4 gv[2], bv[2], sv[2], rp[2];
#define RH_ROFF(ai_, m_, bj_) ((size_t)((ai_) * HALF + (m_) * 16) * 2048 + (bj_) * HALF)
#define RH_LOAD(HB, FB, k) do { const int bj_ = (k) / (8 / NR), ai_ = ((k) / (4 / NR)) & 1, mb_ = ((k) % (4 / NR)) * NR; _Pragma("unroll") for (int m = mb_; m < mb_ + NR; ++m) { \
            if constexpr (BASEF32) { const char* p_ = b_u + RH_ROFF(ai_, m, bj_) * 4; FB[m & (NR - 1)][0] = *(const f32x4*)(p_ + vo4); FB[m & (NR - 1)][1] = *(const f32x4*)(p_ + 16 + vo4); } \
            else HB[m & (NR - 1)] = *(const u32x4*)(b_u + RH_ROFF(ai_, m, bj_) * 2 + vo2n); } } while (0)
#define RH_PIN(HB, FB) do { if constexpr (BASEF32) asm volatile("" : "+v"(FB[0][0]), "+v"(FB[0][1]), "+v"(FB[1][0]), "+v"(FB[1][1]) :: "memory"); \
            else asm volatile("" : "+v"(HB[0]), "+v"(HB[1]) :: "memory"); } while (0)
#define RH_BODY(HB, FB, k) do { const int bj = (k) / (8 / NR), ai = ((k) / (4 / NR)) & 1, mb = ((k) % (4 / NR)) * NR; \
            if (((k) % (8 / NR)) == 0) { _Pragma("unroll") for (int n = 0; n < 2; ++n) { gv[n] = *(const f32x4*)(g_u + (bj * HALF + n * 4) * 4 + vv); bv[n] = bias ? *(const f32x4*)(bi_u + (bj * HALF + n * 4) * 4 + vv) : (f32x4){0.f, 0.f, 0.f, 0.f}; \
                if constexpr (HAS_NEXT) sv[n] = sigma4(*(const f32x4*)(sc_u + (bj * HALF + n * 4) * 4 + vv)); \
                if constexpr (!BASEF32) { const f32x4 sp = sigma4(*(const f32x4*)(sp_u + (bj * HALF + n * 4) * 4 + vv)); \
                    rp[n] = (f32x4){__builtin_amdgcn_rcpf(sp[0]), __builtin_amdgcn_rcpf(sp[1]), __builtin_amdgcn_rcpf(sp[2]), __builtin_amdgcn_rcpf(sp[3])}; } } } \
            _Pragma("unroll") for (int m = mb; m < mb + NR; ++m) { const size_t ro = RH_ROFF(ai, m, bj) * 2; f32x4 b0, b1; \
                if constexpr (BASEF32) { b0 = FB[m & (NR - 1)][0]; b1 = FB[m & (NR - 1)][1]; } \
                else { const u32x4 hb = quad_tr(HB[m & (NR - 1)], srcb); \
                    b0 = (f32x4){__uint_as_float(hb.x << 16), __uint_as_float(hb.x & 0xffff0000u), __uint_as_float(hb.y << 16), __uint_as_float(hb.y & 0xffff0000u)} * rp[0]; \
                    b1 = (f32x4){__uint_as_float(hb.z << 16), __uint_as_float(hb.z & 0xffff0000u), __uint_as_float(hb.w << 16), __uint_as_float(hb.w & 0xffff0000u)} * rp[1]; } \
                const f32x4 x0 = b0 + gv[0] * (acc[ai][bj][m][0] + bv[0]), x1 = b1 + gv[1] * (acc[ai][bj][m][1] + bv[1]); \
                s2a[ai][m] += ((x0[0] * x0[0] + x0[1] * x0[1]) + (x0[2] * x0[2] + x0[3] * x0[3])) + ((x1[0] * x1[0] + x1[1] * x1[1]) + (x1[2] * x1[2] + x1[3] * x1[3])); \
                if constexpr (HAS_NEXT) { const u32x2 lo = pack4(x0 * sv[0]), hi = pack4(x1 * sv[1]); *(u32x4*)(const_cast<char*>(xa_u) + ro + vo2) = (u32x4){lo.x, lo.y, hi.x, hi.y}; } \
                else { const u32x2 lo = pack4h(x0), hi = pack4h(x1); *(u32x4*)(const_cast<char*>(xf_u) + ro + vo2) = (u32x4){lo.x, lo.y, hi.x, hi.y}; } } \
            asm volatile("" ::: "memory"); } while (0)
        if constexpr (BASEF32) {
#pragma unroll
            for (int k = 0; k < 8; ++k) { RH_LOAD(hb0, fb0, k); asm volatile("s_waitcnt vmcnt(0)" ::: "memory"); RH_PIN(hb0, fb0); RH_BODY(hb0, fb0, k); }
        } else {
        RH_LOAD(hb0, fb0, 0); asm volatile("" ::: "memory");
        RH_LOAD(hb1, fb1, 1); asm volatile("s_waitcnt vmcnt(%0)" :: "n"(NLD) : "memory"); RH_PIN(hb0, fb0);
        RH_BODY(hb0, fb0, 0);
#define RH_STEP(HBa, FBa, HBb, FBb, k) do { RH_LOAD(HBa, FBa, (k) + 1); asm volatile("s_waitcnt vmcnt(%0)" :: "n"(NLD + NST) : "memory"); RH_PIN(HBb, FBb); RH_BODY(HBb, FBb, k); } while (0)
        RH_STEP(hb0, fb0, hb1, fb1, 1); RH_STEP(hb1, fb1, hb0, fb0, 2); RH_STEP(hb0, fb0, hb1, fb1, 3); RH_STEP(hb1, fb1, hb0, fb0, 4); RH_STEP(hb0, fb0, hb1, fb1, 5); RH_STEP(hb1, fb1, hb0, fb0, 6);
#undef RH_STEP
        asm volatile("s_waitcnt vmcnt(%0)" :: "n"(NST) : "memory"); RH_PIN(hb1, fb1);
        RH_BODY(hb1, fb1, 7);
        }
#undef RH_ROFF
#undef RH_LOAD
#undef RH_PIN
#undef RH_BODY
#pragma unroll
        for (int ai = 0; ai < 2; ++ai)
#pragma unroll
            for (int m = 0; m < 4; ++m) { float s2 = s2a[ai][m]; s2 += xl_xor(s2, lane_, 16); s2 += xl_xor(s2, lane_, 32);
                if (fq == 0) red[wc * 256 + ai * HALF + wr * 64 + m * 16 + fr] = s2; }
        asm volatile("s_waitcnt lgkmcnt(0)" ::: "memory"); __builtin_amdgcn_s_barrier(); asm volatile("" ::: "memory");
        if (wc == 0) { const int l = lane_;
#pragma unroll
            for (int ai = 0; ai < 2; ++ai) { const int idx = ai * HALF + wr * 64 + l; const float v = (red[idx] + red[256 + idx]) + (red[512 + idx] + red[768 + idx]);
                if (ssn) ssn[(size_t)u.pn * SS_PSTRIDE + u.pm * BM + idx] = v; } }
    }
};
template <class Epi, class Sched, bool ALIGN_EPI = false, bool SP2 = false>
__device__ __forceinline__ void gemm_phase(PG8_LAS unsigned char* lds, const Gemm g, const Sched& S, const Epi& E, const int wv) {
    int lane; asm volatile("v_mbcnt_lo_u32_b32 %0, -1, 0\n\tv_mbcnt_hi_u32_b32 %0, -1, %0" : "=v"(lane));
    const int wid = wv, tid = wv * 64 + lane, wr = wid >> 2, wc = wid & 3, fr = lane & 15, fq = lane >> 4;
    const int K = g.K, nt = K / BK;
    unsigned voffA[2], voffB[2];
#pragma unroll
    for (int i = 0; i < 2; ++i) { int R, C; stage_rc(tid * 16 + i * 8192, R, C); const int Rb = Epi::PERM ? ((R & ~31) + perm32(R & 31)) : R;
        voffA[i] = (unsigned)(R * K + C) * 2u; voffB[i] = (unsigned)(Rb * K + C) * 2u; }
    const size_t kstep = (size_t)(BK * 2);
    const size_t hstep = (size_t)HALF * K * 2;
    const size_t tstep = 2 * hstep;
    const unsigned ldsw = (unsigned)wid * 1024u;
    const int aoff = lds_byte(wr * 64 + fr, fq * 8), boff = lds_byte(wc * 32 + fr, fq * 8);
#define PG8_SA(b, h) (((b) * 2 + (h)) * HTB)
#define PG8_SB(b, h) ((4 + (b) * 2 + (h)) * HTB)
#define PG8_STAGE(bufoff, gbase, voff) do { _Pragma("unroll") for (int _i = 0; _i < 2; ++_i) \
        __builtin_amdgcn_global_load_lds((const unsigned*)((const char*)(gbase) + (voff)[_i]), (PG8_LAS unsigned*)(lds + (bufoff) + ldsw + _i * 8192), 16, 0, 0); } while (0)
#define PG8_LDA(dst, b, h) do { _Pragma("unroll") for (int m = 0; m < 4; ++m) _Pragma("unroll") for (int k = 0; k < 2; ++k) dst[m][k] = *(const PG8_LAS bf16x8*)(lds + PG8_SA(b, h) + aoff + m * 2048 + k * 1024); } while (0)
#define PG8_LDB(dst, b, h) do { _Pragma("unroll") for (int n = 0; n < 2; ++n) _Pragma("unroll") for (int k = 0; k < 2; ++k) dst[n][k] = *(const PG8_LAS bf16x8*)(lds + PG8_SB(b, h) + boff + n * 2048 + k * 1024); } while (0)
#define PG8_MMA(ai, bj, At, Bt) do { __builtin_amdgcn_s_setprio(1); _Pragma("unroll") for (int m = 0; m < 4; ++m) _Pragma("unroll") for (int n = 0; n < 2; ++n) _Pragma("unroll") for (int k = 0; k < 2; ++k) \
        acc[ai][bj][m][n] = mma16<Epi::F16>(Bt[n][k], At[m][k], acc[ai][bj][m][n]); __builtin_amdgcn_s_setprio(0); } while (0)
#define PG8_WAIT_V(n) asm volatile("s_waitcnt vmcnt(" #n ")" ::: "memory")
#define PG8_WAIT_L(n) asm volatile("s_waitcnt lgkmcnt(" #n ")" ::: "memory")
#define PG8_BAR __builtin_amdgcn_s_barrier()
#define PG8_SCHED __builtin_amdgcn_sched_barrier(0)
    Unit cur, nxt; int ui = 0;
    if (!S.next(0, cur)) return;
    f32x4 acc[2][2][4][2];
#pragma unroll
    for (int a = 0; a < 2; ++a)
#pragma unroll
        for (int b = 0; b < 2; ++b)
#pragma unroll
            for (int m = 0; m < 4; ++m)
#pragma unroll
                for (int n = 0; n < 2; ++n) acc[a][b][m][n] = (f32x4){0.f, 0.f, 0.f, 0.f};
    bf16x8 At[4][2], B0[2][2], B1[2][2];
    const char* cA = (const char*)g.A + (size_t)cur.pm * tstep; const char* cB = (const char*)g.Bt + (size_t)cur.pn * tstep;
    S.a_ready(cur);
    float epre = E.prefetch(cur, tid);
    if constexpr (SP2) {
        PG8_STAGE(PG8_SB(0, 0), cB, voffB); PG8_STAGE(PG8_SB(0, 1), cB + hstep, voffB); PG8_STAGE(PG8_SA(0, 0), cA, voffA); PG8_STAGE(PG8_SA(0, 1), cA + hstep, voffA);
        if (wr == 1) PG8_BAR;
        PG8_WAIT_V(2); PG8_BAR;
        PG8_STAGE(PG8_SB(1, 0), cB + kstep, voffB); PG8_STAGE(PG8_SA(1, 0), cA + kstep, voffA); PG8_STAGE(PG8_SB(1, 1), cB + hstep + kstep, voffB);
        PG8_WAIT_V(6); PG8_BAR;
    } else {
        PG8_STAGE(PG8_SB(0, 0), cB, voffB); PG8_STAGE(PG8_SA(0, 0), cA, voffA); PG8_STAGE(PG8_SB(0, 1), cB + hstep, voffB); PG8_STAGE(PG8_SA(0, 1), cA + hstep, voffA);
        if (wr == 1) PG8_BAR;
        PG8_WAIT_V(4); PG8_BAR;
        PG8_STAGE(PG8_SB(1, 0), cB + kstep, voffB); PG8_STAGE(PG8_SA(1, 0), cA + kstep, voffA); PG8_STAGE(PG8_SB(1, 1), cB + hstep + kstep, voffB);
        PG8_WAIT_V(6); PG8_BAR;
    }
    for (;;) {
        const bool has_next = S.next(ui + 1, nxt);
        const char* nA = has_next ? (const char*)g.A + (size_t)nxt.pm * tstep : cA; const char* nB = has_next ? (const char*)g.Bt + (size_t)nxt.pn * tstep : cB;
        for (int t = 0; t < nt; t += 2) {
            const bool last = (t == nt - 2);
            const char* a1 = cA + (size_t)(t + 1) * kstep;
            const char* a2 = last ? nA : cA + (size_t)(t + 2) * kstep; const char* b2 = last ? nB : cB + (size_t)(t + 2) * kstep;
            const char* a3 = a2 + kstep; const char* b3 = b2 + kstep;
            if (last && has_next) S.a_ready(nxt);
            if constexpr (SP2) {
            PG8_LDB(B0, 0, 0); PG8_LDB(B1, 0, 1); PG8_SCHED; PG8_LDA(At, 0, 0); PG8_STAGE(PG8_SA(1, 1), a1 + hstep, voffA);
            PG8_WAIT_V(8); PG8_WAIT_L(0); PG8_BAR; PG8_MMA(0, 0, At, B0); PG8_MMA(0, 1, At, B1); PG8_BAR; PG8_SCHED;
            PG8_LDA(At, 0, 1); PG8_STAGE(PG8_SB(0, 0), b2, voffB); PG8_STAGE(PG8_SB(0, 1), b2 + hstep, voffB); PG8_STAGE(PG8_SA(0, 0), a2, voffA);
            PG8_WAIT_V(8); PG8_WAIT_L(0); PG8_BAR; PG8_MMA(1, 0, At, B0); PG8_MMA(1, 1, At, B1); PG8_BAR; PG8_SCHED;
            PG8_LDB(B0, 1, 0); PG8_LDB(B1, 1, 1); PG8_SCHED; PG8_LDA(At, 1, 0); PG8_STAGE(PG8_SA(0, 1), a2 + hstep, voffA);
            PG8_WAIT_V(8); PG8_WAIT_L(0); PG8_BAR; PG8_MMA(0, 0, At, B0); PG8_MMA(0, 1, At, B1); PG8_BAR; PG8_SCHED;
            PG8_LDA(At, 1, 1); PG8_STAGE(PG8_SB(1, 0), b3, voffB); PG8_STAGE(PG8_SB(1, 1), b3 + hstep, voffB); PG8_STAGE(PG8_SA(1, 0), a3, voffA);
            PG8_WAIT_V(8); PG8_WAIT_L(0); PG8_BAR; PG8_MMA(1, 0, At, B0); PG8_MMA(1, 1, At, B1); PG8_BAR; PG8_SCHED;
            } else {
            PG8_LDB(B0, 0, 0); PG8_SCHED; PG8_LDA(At, 0, 0); PG8_STAGE(PG8_SA(1, 1), a1 + hstep, voffA);
            PG8_WAIT_L(8); PG8_BAR; PG8_WAIT_L(0); PG8_MMA(0, 0, At, B0); PG8_BAR; PG8_SCHED;
            PG8_LDB(B1, 0, 1); PG8_STAGE(PG8_SB(0, 0), b2, voffB);
            PG8_BAR; PG8_WAIT_L(0); PG8_MMA(0, 1, At, B1); PG8_BAR;
            PG8_LDA(At, 0, 1); PG8_STAGE(PG8_SA(0, 0), a2, voffA);
            PG8_BAR; PG8_WAIT_L(0); PG8_MMA(1, 0, At, B0); PG8_BAR; PG8_SCHED;
            PG8_STAGE(PG8_SB(0, 1), b2 + hstep, voffB);
            PG8_WAIT_V(6); PG8_BAR; PG8_MMA(1, 1, At, B1); PG8_BAR;
            PG8_LDB(B0, 1, 0); PG8_SCHED; PG8_LDA(At, 1, 0); PG8_STAGE(PG8_SA(0, 1), a2 + hstep, voffA);
            PG8_WAIT_L(8); PG8_BAR; PG8_WAIT_L(0); PG8_MMA(0, 0, At, B0); PG8_BAR; PG8_SCHED;
            PG8_LDB(B1, 1, 1); PG8_STAGE(PG8_SB(1, 0), b3, voffB);
            PG8_BAR; PG8_WAIT_L(0); PG8_MMA(0, 1, At, B1); PG8_BAR;
            PG8_LDA(At, 1, 1); PG8_STAGE(PG8_SA(1, 0), a3, voffA);
            PG8_BAR; PG8_WAIT_L(0); PG8_MMA(1, 0, At, B0); PG8_BAR; PG8_SCHED;
            PG8_STAGE(PG8_SB(1, 1), b3 + hstep, voffB);
            PG8_WAIT_V(6); PG8_BAR; PG8_MMA(1, 1, At, B1); PG8_BAR;
            }
        }
        if constexpr (ALIGN_EPI) { if (wr == 0) PG8_BAR; }
        if constexpr (!Epi::AFTER_DRAIN) { E(acc, cur, wr, wc, fr, fq, epre); S.done(cur); }
        if (!has_next) break;
#pragma unroll
        for (int a = 0; a < 2; ++a)
#pragma unroll
            for (int b = 0; b < 2; ++b)
#pragma unroll
                for (int m = 0; m < 4; ++m)
#pragma unroll
                    for (int n = 0; n < 2; ++n) acc[a][b][m][n] = (f32x4){0.f, 0.f, 0.f, 0.f};
        cur = nxt; cA = nA; cB = nB; ++ui;
        epre = E.prefetch(cur, tid);
        if constexpr (ALIGN_EPI) { if (wr == 1) PG8_BAR; }
    }
    PG8_WAIT_V(0);
    if constexpr (!ALIGN_EPI) { if (wr == 0) PG8_BAR; }
    PG8_BAR;
    if constexpr (Epi::AFTER_DRAIN) { E.fused(acc, cur, wr, wc, fr, fq, lds, wid, lane); S.done(cur); }
#undef PG8_SA
#undef PG8_SB
#undef PG8_STAGE
#undef PG8_LDA
#undef PG8_LDB
#undef PG8_MMA
#undef PG8_WAIT_V
#undef PG8_WAIT_L
#undef PG8_BAR
#undef PG8_SCHED
}
}

namespace att {
typedef unsigned short bf16_t;
typedef short bf16x8 __attribute__((ext_vector_type(8)));
typedef short s16x4 __attribute__((ext_vector_type(4)));
typedef float f32x16 __attribute__((ext_vector_type(16)));
typedef float f32x4 __attribute__((ext_vector_type(4)));
typedef unsigned u32x4 __attribute__((ext_vector_type(4)));
constexpr int D = 128;
constexpr float SCALE = 0.08838834764831845f;
constexpr float THR = 8.f;
constexpr int NW = 8, QBLK = 32, KVBLK = 64, QB = NW * QBLK;
constexpr int SHM_V = KVBLK * D * 2, SHM_K = KVBLK * D * 2;
constexpr int LDS_BYTES = 2 * SHM_V + 2 * SHM_K + NW * 64 * 4;

#define KSWZ(row, colB) ((row) * 256 + ((colB) ^ (((row) & 7) << 4)))
#define SBAR() __builtin_amdgcn_sched_barrier(0)
__device__ __forceinline__ int v_st(int k, int c) { const int kk = (k & ~0xC) | ((k & 4) << 1) | ((k & 8) >> 1); return ((kk >> 3) * 4 + (c >> 5)) * 512 + ((kk & 7) * 32 + (c & 31)) * 2; }
__device__ __forceinline__ int v_rd_base(int lane) { return ((lane & 3) << 3) | (((lane >> 2) & 3) << 6) | (((lane >> 4) & 1) << 5) | (((lane >> 5) & 1) << 8); }
constexpr int v_rd_off(int d0, int ks, int half) { return d0 * 512 + ks * 4096 + half * 2048; }
__device__ __forceinline__ int crow(int r, int hi) { return (r & 3) + 8 * (r >> 2) + 4 * hi; }
__device__ __forceinline__ unsigned cvtpk(float lo, float hi) { unsigned r; asm volatile("v_cvt_pk_bf16_f32 %0, %1, %2" : "=v"(r) : "v"(lo), "v"(hi)); return r; }
__device__ __forceinline__ bf16x8 load8(const bf16_t* p) { return *reinterpret_cast<const bf16x8*>(p); }
__device__ __forceinline__ void mask_tile(f32x16& p0, f32x16& p1, int dq, unsigned W) {
    const float NEG = -__builtin_inff();
#pragma unroll
    for (int r = 0; r < 16; ++r) {
        const int c = (r & 3) + 8 * (r >> 2);
        if ((unsigned)(dq - c) >= W) p0[r] = NEG;
        if ((unsigned)(dq - c - 32) >= W) p1[r] = NEG;
    }
}
__device__ __forceinline__ void mask_all(f32x16& p0, f32x16& p1, bool kill) {
    const float NEG = -__builtin_inff();
#pragma unroll
    for (int r = 0; r < 16; ++r) { if (kill) p0[r] = NEG; if (kill) p1[r] = NEG; }
}
__device__ __forceinline__ void partialSM(f32x16& p0, f32x16& p1, float& m_reg, float& mn, float& alpha) {
    float pmax = p0[0]; for (int r = 1; r < 16; ++r) pmax = fmaxf(pmax, p0[r]); for (int r = 0; r < 16; ++r) pmax = fmaxf(pmax, p1[r]);
    { auto rr = __builtin_amdgcn_permlane32_swap(__float_as_uint(pmax), __float_as_uint(pmax), false, false);
      pmax = fmaxf(__uint_as_float(rr[0]), __uint_as_float(rr[1])); }
    constexpr float C2 = 1.4426950408889634f * SCALE;
    if (__builtin_expect(__all((pmax - m_reg) * SCALE <= THR), 1)) { mn = m_reg; alpha = 1.f; }
    else { mn = fmaxf(m_reg, pmax); alpha = __builtin_amdgcn_exp2f((m_reg - mn) * C2); m_reg = mn; }
    const float mnL = -mn * C2;
    for (int r = 0; r < 16; ++r) p0[r] = fmaf(p0[r], C2, mnL); for (int r = 0; r < 16; ++r) p1[r] = fmaf(p1[r], C2, mnL);
    for (int r = 0; r < 16; ++r) p0[r] = __builtin_amdgcn_exp2f(p0[r]);
}
__device__ __forceinline__ void finishSM(f32x16& p0, f32x16& p1, float alpha, float& l_reg, bf16x8& pa0, bf16x8& pa1, bf16x8& pa2, bf16x8& pa3) {
    for (int r = 0; r < 16; ++r) p1[r] = __builtin_amdgcn_exp2f(p1[r]);
    float ps = 0; for (int r = 0; r < 16; ++r) ps += p0[r]; for (int r = 0; r < 16; ++r) ps += p1[r];
    { auto rr = __builtin_amdgcn_permlane32_swap(__float_as_uint(ps), __float_as_uint(ps), false, false);
      ps = __uint_as_float(rr[0]) + __uint_as_float(rr[1]); }
    l_reg = l_reg * alpha + ps;
#define PK4(P, B_, OUT) do { unsigned a0 = cvtpk(P[B_+0], P[B_+1]), a1 = cvtpk(P[B_+2], P[B_+3]);                          \
        unsigned b0 = cvtpk(P[B_+4], P[B_+5]), b1 = cvtpk(P[B_+6], P[B_+7]);                                             \
        auto r0 = __builtin_amdgcn_permlane32_swap(a0, b0, false, false); auto r1 = __builtin_amdgcn_permlane32_swap(a1, b1, false, false); \
        u32x4 w = {r0[0], r1[0], r0[1], r1[1]}; OUT = *reinterpret_cast<bf16x8*>(&w); } while (0)
    PK4(p0, 0, pa0); PK4(p0, 8, pa1); PK4(p1, 0, pa2); PK4(p1, 8, pa3);
#undef PK4
}
template <int KB>
__device__ __forceinline__ void qkt(f32x16& p0, f32x16& p1, const char* K_lds, int r32, int hi, const bf16x8* qr) {
    p0 = f32x16{}; p1 = f32x16{};
    unsigned kb[4];
#pragma unroll
    for (int dd = 0; dd < 4; ++dd) kb[dd] = (unsigned)(uintptr_t)K_lds + KB * SHM_K + KSWZ(r32, (dd * 16 + hi * 8) * 2);
#define KRD(dst, i) asm volatile("ds_read_b128 %0, %1 offset:%2" : "=&v"(dst) : "v"(kb[((i) >> 1) & 3]), "i"((((i) >> 1) >> 2) * 128 + ((i) & 1) * 8192) : "memory")
#define KMMA(f, i) do { if (((i) & 1) == 0) p0 = __builtin_amdgcn_mfma_f32_32x32x16_bf16(f, qr[(i) >> 1], p0, 0, 0, 0); else p1 = __builtin_amdgcn_mfma_f32_32x32x16_bf16(f, qr[(i) >> 1], p1, 0, 0, 0); } while (0)
#define KW(n) do { asm volatile("s_waitcnt lgkmcnt(" #n ")" ::: "memory"); SBAR(); } while (0)
    bf16x8 f0, f1, f2;
    KRD(f0, 0); KRD(f1, 1);
#define K3(i) do { KRD(f2, (i) + 2); KW(2); KMMA(f0, i); SBAR(); KRD(f0, (i) + 3); KW(2); KMMA(f1, (i) + 1); SBAR(); KRD(f1, (i) + 4); KW(2); KMMA(f2, (i) + 2); SBAR(); } while (0)
    K3(0); K3(3); K3(6); K3(9);
    KRD(f2, 14); KW(2); KMMA(f0, 12); SBAR(); KRD(f0, 15); KW(2); KMMA(f1, 13); SBAR(); KW(1); KMMA(f2, 14); SBAR(); KW(0); KMMA(f0, 15);
#undef K3
#undef KW
#undef KMMA
#undef KRD
}
template <int VB>
__device__ __forceinline__ void pv_tile(f32x16* o, int vb0, bf16x8 pa0, bf16x8 pa1, bf16x8 pa2, bf16x8 pa3) {
#define TRRD(dst, off) asm volatile("ds_read_b64_tr_b16 %0, %1 offset:%2" : "=&v"(dst) : "v"(vb0), "i"(off) : "memory")
#define LDA(d0) do { constexpr int b_ = VB * SHM_V + v_rd_off(d0, 0, 0); TRRD(l0, b_); TRRD(h0, b_ + 2048); TRRD(l1, b_ + 4096); TRRD(h1, b_ + 6144); } while (0)
#define LDB(d0) do { constexpr int b_ = VB * SHM_V + v_rd_off(d0, 0, 0); TRRD(l2, b_ + 8192); TRRD(h2, b_ + 10240); TRRD(l3, b_ + 12288); TRRD(h3, b_ + 14336); } while (0)
#define MMA01(d0) do { \
        o[d0] = __builtin_amdgcn_mfma_f32_32x32x16_bf16(pa0, (bf16x8){l0[0], l0[1], l0[2], l0[3], h0[0], h0[1], h0[2], h0[3]}, o[d0], 0, 0, 0);   \
        o[d0] = __builtin_amdgcn_mfma_f32_32x32x16_bf16(pa1, (bf16x8){l1[0], l1[1], l1[2], l1[3], h1[0], h1[1], h1[2], h1[3]}, o[d0], 0, 0, 0); } while (0)
#define MMA23(d0) do { \
        o[d0] = __builtin_amdgcn_mfma_f32_32x32x16_bf16(pa2, (bf16x8){l2[0], l2[1], l2[2], l2[3], h2[0], h2[1], h2[2], h2[3]}, o[d0], 0, 0, 0);   \
        o[d0] = __builtin_amdgcn_mfma_f32_32x32x16_bf16(pa3, (bf16x8){l3[0], l3[1], l3[2], l3[3], h3[0], h3[1], h3[2], h3[3]}, o[d0], 0, 0, 0); } while (0)
#define W4() do { asm volatile("s_waitcnt lgkmcnt(4)" ::: "memory"); SBAR(); } while (0)
#define W0() do { asm volatile("s_waitcnt lgkmcnt(0)" ::: "memory"); SBAR(); } while (0)
    s16x4 l0, l1, l2, l3, h0, h1, h2, h3;
    LDA(0);
#define STEP(d0) do { LDB(d0); W4(); MMA01(d0); SBAR(); LDA((d0) + 1); W4(); MMA23(d0); SBAR(); } while (0)
    STEP(0); STEP(1); STEP(2);
    LDB(3); W4(); MMA01(3); SBAR(); W0(); MMA23(3);
#undef STEP
#undef W0
#undef W4
#undef MMA23
#undef MMA01
#undef LDB
#undef LDA
#undef TRRD
}

struct BlockRef { const bf16_t* Q; const bf16_t* K; const bf16_t* V; bf16_t* O; const unsigned long long* RM; int P0; };
struct Seam { bf16x8 qr[8]; bf16x8 st_v0, st_v1, st_k0, st_k1; };
#define VMW() asm volatile("s_waitcnt vmcnt(0)" ::: "memory")
#define VMWN(n) asm volatile("s_waitcnt vmcnt(%0)" :: "i"(n) : "memory")
#define SLOAD_H(Kp, Vp, k0) do { const char* kt_ = (const char*)(Kp) + (size_t)(k0) * (LD * 2); const char* vt_ = (const char*)(Vp) + (size_t)(k0) * (LD * 2);              \
                         S.st_v0 = *(const bf16x8*)(vt_ + voff); S.st_v1 = *(const bf16x8*)(vt_ + 32 * LD * 2 + voff);              \
                         S.st_k0 = *(const bf16x8*)(kt_ + voff); S.st_k1 = *(const bf16x8*)(kt_ + 32 * LD * 2 + voff); } while (0)
#define SWRITE_HK(bf) do { *(bf16x8*)(K_lds + (bf) * SHM_K + kws) = S.st_k0; *(bf16x8*)(K_lds + (bf) * SHM_K + kws + 32 * 256) = S.st_k1; } while (0)
#define SWRITE_HV(bf) do { *(bf16x8*)(V_lds + (bf) * SHM_V + vst0) = S.st_v0; *(bf16x8*)(V_lds + (bf) * SHM_V + vst1) = S.st_v1; } while (0)
#define SWRITE_H(bf) do { SWRITE_HV(bf); SWRITE_HK(bf); } while (0)
template <int LD>
__device__ __forceinline__ void causal_prime(const BlockRef& cur, char* lds, Seam& S, const int tid) {
    const int wid = __builtin_amdgcn_readfirstlane(tid >> 6), lane = tid & 63, r32 = lane & 31, hi = lane >> 5;
    const int sr = tid >> 4, sc = (tid & 15) * 8, kws = KSWZ(sr, sc * 2); char* K_lds = lds + 2 * SHM_V;
    const unsigned voff = (unsigned)(sr * LD + sc) * 2u, qoff = (unsigned)(r32 * LD + hi * 8) * 2u;
    { const char* qb_ = (const char*)cur.Q + (size_t)(wid * QBLK) * (LD * 2);
      for (int d0 = 0; d0 < 8; ++d0) S.qr[d0] = *(const bf16x8*)(qb_ + qoff + d0 * 32); }
    SLOAD_H(cur.K, cur.V, 0); VMW(); SWRITE_HK(0);
    __syncthreads();
}
template <int LD, int LDO, bool MOBA>
__device__ __forceinline__ void causal_block(const BlockRef& cur, const BlockRef& nxt, char* lds, Seam& S, const int tid) {
    const int wid = __builtin_amdgcn_readfirstlane(tid >> 6), lane = tid & 63, r32 = lane & 31, hi = lane >> 5;
    constexpr int W = 1 << 30;
    const int NT = (cur.P0 + QB - 1) / KVBLK + 1;
    const int qlo = cur.P0 + wid * QBLK, qm = qlo + r32 - 4 * hi;
    char* V_lds = lds; char* K_lds = lds + 2 * SHM_V;
    float* ws = (float*)(lds + 2 * SHM_V + 2 * SHM_K) + wid * 64; float* li_l = ws, * al_l = ws + 32;
    float m_reg = -1e30f, l_reg = 0; f32x16 o[4] = {};
    const int sr = tid >> 4, sc = (tid & 15) * 8, vst0 = v_st(sr, sc), vst1 = v_st(32 + sr, sc), kws = KSWZ(sr, sc * 2);
    const unsigned voff = (unsigned)(sr * LD + sc) * 2u, qoff = (unsigned)(r32 * LD + hi * 8) * 2u;
    const int vb0 = (int)(uintptr_t)V_lds + v_rd_base(lane);
    const bf16_t* Kh = cur.K; const bf16_t* Vh = cur.V;
    unsigned* rm_l = (unsigned*)(lds + LDS_BYTES) + wid * 64;
    if constexpr (MOBA) { const unsigned long long rmask = cur.RM[(size_t)(wid * QBLK + r32) * 8]; if (hi == 0) { rm_l[2 * r32] = (unsigned)rmask; rm_l[2 * r32 + 1] = (unsigned)(rmask >> 32); } }
#define RESC(a) do { if (__any((a) < 1.f)) { if (hi == 0) al_l[r32] = (a); asm volatile("s_waitcnt lgkmcnt(0)" ::: "memory");              \
                     for (int d_ = 0; d_ < 4; ++d_) for (int r = 0; r < 16; ++r) o[d_][r] *= al_l[crow(r, hi)]; } } while (0)
#define KBASE(t) ((t) * KVBLK)
#define MASKT(P0_, P1_, t) do { const int kb_ = KBASE(t); if (kb_ + KVBLK - 1 > qlo || kb_ <= qlo + QBLK - 1 - W) mask_tile(P0_, P1_, qm - kb_, (unsigned)W); \
                                if constexpr (MOBA) { const int blk_ = kb_ >> 8; const unsigned mw_ = rm_l[2 * r32 + (blk_ >> 5)]; mask_all(P0_, P1_, ((mw_ >> (blk_ & 31)) & 1u) == 0u); } } while (0)
    constexpr int NQL = 8;
#define SEAM_K0() do { VMWN(NQL); SWRITE_HK(0); SBAR(); } while (0)
    f32x16 pA0, pA1, pB0, pB1; float mnA, mnB, alA, alB; bf16x8 pa0, pa1, pa2, pa3;
    SWRITE_HV(0); SBAR();
    if (NT > 1) { SLOAD_H(Kh, Vh, KBASE(1)); }
    SBAR(); qkt<0>(pA0, pA1, K_lds, r32, hi, S.qr);
    MASKT(pA0, pA1, 0); partialSM(pA0, pA1, m_reg, mnA, alA);
    if (NT > 1) { VMW(); SWRITE_H(1); }
    __syncthreads();
#define HALF_STEP(PX0, PX1, mnX, alX, PY0, PY1, alY, t, KB, VB, SB) do {                                                      \
        SBAR(); qkt<KB>(PX0, PX1, K_lds, r32, hi, S.qr);                                             \
        finishSM(PY0, PY1, alY, l_reg, pa0, pa1, pa2, pa3); SBAR();                                                           \
        if ((t) + 1 < NT) { SLOAD_H(Kh, Vh, KBASE((t) + 1)); SBAR(); }                                               \
        pv_tile<VB>(o, vb0, pa0, pa1, pa2, pa3); MASKT(PX0, PX1, (t)); partialSM(PX0, PX1, m_reg, mnX, alX);                                        \
        __syncthreads();                                                                                                      \
        if ((t) + 1 < NT) { VMW(); SWRITE_H(SB); }                                                                          \
        RESC(alX); __syncthreads(); } while (0)
    for (int t = 1; t + 1 < NT; t += 2) {
        HALF_STEP(pB0, pB1, mnB, alB, pA0, pA1, alA, t, 1, 0, 0);
        HALF_STEP(pA0, pA1, mnA, alA, pB0, pB1, alB, t + 1, 0, 1, 1);
    }
    const bool even = (NT & 1) == 0;
    if (even) { SBAR(); qkt<1>(pB0, pB1, K_lds, r32, hi, S.qr); SBAR(); }
    SLOAD_H(nxt.K, nxt.V, 0); SBAR();
    { const char* qb_ = (const char*)nxt.Q + (size_t)(wid * QBLK) * (LD * 2);
#pragma unroll
      for (int d0 = 0; d0 < 8; ++d0) S.qr[d0] = *(const bf16x8*)(qb_ + qoff + d0 * 32); }
    SBAR();
    finishSM(pA0, pA1, alA, l_reg, pa0, pa1, pa2, pa3); SBAR();
    pv_tile<0>(o, vb0, pa0, pa1, pa2, pa3);
    if (even) { MASKT(pB0, pB1, NT - 1); partialSM(pB0, pB1, m_reg, mnB, alB); __syncthreads(); RESC(alB);
        finishSM(pB0, pB1, alB, l_reg, pa0, pa1, pa2, pa3); SBAR(); pv_tile<1>(o, vb0, pa0, pa1, pa2, pa3); }
    SBAR(); SEAM_K0();
    if (hi == 0) li_l[r32] = l_reg; asm volatile("s_waitcnt lgkmcnt(0)" ::: "memory");
    float rli[16];
#pragma unroll
    for (int r = 0; r < 16; ++r) rli[r] = __builtin_amdgcn_rcpf(li_l[crow(r, hi)]);
    const char* ob_ = (const char*)cur.O + (size_t)(wid * QBLK) * (LDO * 2);
    int lane_e; asm volatile("v_mbcnt_lo_u32_b32 %0, -1, 0\n\tv_mbcnt_hi_u32_b32 %0, -1, %0" : "=v"(lane_e));
    const int r32e = lane_e & 31, hie = lane_e >> 5;
    const unsigned ooff = (unsigned)(4 * hie * LDO + r32e) * 2u;
#pragma unroll
    for (int r = 0; r < 16; ++r) { const char* orp_ = ob_ + (size_t)((r & 3) + 8 * (r >> 2)) * (LDO * 2);
#pragma unroll
        for (int d0 = 0; d0 < 4; ++d0) { const float v = o[d0][r] * rli[r];
            const float vn = xl_xor(v, lane_e, 1);
            if ((r32e & 1) == 0) *(unsigned*)(orp_ + d0 * 64 + ooff) = cvtpk(v, vn); } }
    __syncthreads();
#undef RESC
#undef KBASE
#undef MASKT
#undef SEAM_K0
#undef HALF_STEP
}

struct SparseRef { const bf16_t* Qb; const bf16_t* K; const bf16_t* V; const unsigned* list; int q0; int nrows; unsigned dbase; int causal; };
constexpr unsigned SP_TRASH = 32768u * 8u * 4u;
constexpr int SP_TAB = LDS_BYTES;
__device__ __forceinline__ void sp_entry(const SparseRef& R, int ridx, unsigned& qrow, unsigned& dest) {
    unsigned e; bool valid = true;
    if (R.list) { valid = ridx < R.nrows; e = R.list[valid ? ridx : 0]; } else e = (unsigned)(R.q0 + ridx) | (3u << 14);
    qrow = e & 16383u; dest = valid ? R.dbase + qrow * 32u + (e >> 14) : SP_TRASH;
}
template <int LD>
__device__ __forceinline__ void sparse_prime(const SparseRef& cur, char* lds, Seam& S, const int tid) {
    const int wid = __builtin_amdgcn_readfirstlane(tid >> 6), lane = tid & 63, r32 = lane & 31, hi = lane >> 5;
    const int sr = tid >> 4, sc = (tid & 15) * 8, kws = KSWZ(sr, sc * 2); char* K_lds = lds + 2 * SHM_V;
    const unsigned voff = (unsigned)(sr * LD + sc) * 2u;
    unsigned* tab = (unsigned*)(lds + SP_TAB) + wid * 128;
    unsigned qrow, dest; sp_entry(cur, wid * QBLK + r32, qrow, dest);
    if (hi == 0) tab[32 + r32] = dest;
    { const char* qb_ = (const char*)cur.Qb; const unsigned qoff = (qrow * (unsigned)LD + (unsigned)hi * 8u) * 2u;
      for (int d0 = 0; d0 < 8; ++d0) S.qr[d0] = *(const bf16x8*)(qb_ + qoff + d0 * 32); }
    SLOAD_H(cur.K, cur.V, 0); VMW(); SWRITE_HK(0);
    __syncthreads();
}
template <int LD>
__device__ __forceinline__ void sparse_block(const SparseRef& cur, const SparseRef& nxt, bf16_t* PART, float* ML, char* lds, Seam& S, const int tid) {
    const int wid = __builtin_amdgcn_readfirstlane(tid >> 6), lane = tid & 63, r32 = lane & 31, hi = lane >> 5;
    constexpr int W = 1 << 30; constexpr int NT = 4;
    const int qlo = wid * QBLK, qm = qlo + r32 - 4 * hi;
    char* V_lds = lds; char* K_lds = lds + 2 * SHM_V;
    float* ws = (float*)(lds + 2 * SHM_V + 2 * SHM_K) + wid * 64; float* li_l = ws, * al_l = ws + 32;
    unsigned* tab = (unsigned*)(lds + SP_TAB) + wid * 128;
    float m_reg = -1e30f, l_reg = 0; f32x16 o[4] = {};
    const int sr = tid >> 4, sc = (tid & 15) * 8, vst0 = v_st(sr, sc), vst1 = v_st(32 + sr, sc), kws = KSWZ(sr, sc * 2);
    const unsigned voff = (unsigned)(sr * LD + sc) * 2u;
    const int vb0 = (int)(uintptr_t)V_lds + v_rd_base(lane);
    const bf16_t* Kh = cur.K; const bf16_t* Vh = cur.V;
    const bool causal = cur.causal != 0;
    if (hi == 0) tab[64 + r32] = tab[32 + r32];
#define RESC(a) do { if (__any((a) < 1.f)) { if (hi == 0) al_l[r32] = (a); asm volatile("s_waitcnt lgkmcnt(0)" ::: "memory");              \
                     for (int d_ = 0; d_ < 4; ++d_) for (int r = 0; r < 16; ++r) o[d_][r] *= al_l[crow(r, hi)]; } } while (0)
#define KBASE(t) ((t) * KVBLK)
#define MASKT(P0_, P1_, t) do { const int kb_ = KBASE(t); if (causal && (kb_ + KVBLK - 1 > qlo)) mask_tile(P0_, P1_, qm - kb_, (unsigned)W); } while (0)
    constexpr int NQL = 8;
#define SEAM_K0() do { VMWN(NQL); SWRITE_HK(0); SBAR(); } while (0)
    f32x16 pA0, pA1, pB0, pB1; float mnA, mnB, alA, alB; bf16x8 pa0, pa1, pa2, pa3;
    SWRITE_HV(0); SBAR();
    SLOAD_H(Kh, Vh, KBASE(1));
    unsigned nq_, nd_; sp_entry(nxt, wid * QBLK + r32, nq_, nd_);
    SBAR(); qkt<0>(pA0, pA1, K_lds, r32, hi, S.qr);
    MASKT(pA0, pA1, 0); partialSM(pA0, pA1, m_reg, mnA, alA);
    VMW(); SWRITE_H(1);
    if (hi == 0) { tab[r32] = nq_; tab[32 + r32] = nd_; }
    __syncthreads();
#define HALF_STEP(PX0, PX1, mnX, alX, PY0, PY1, alY, t, KB, VB, SB) do {                                                      \
        SBAR(); qkt<KB>(PX0, PX1, K_lds, r32, hi, S.qr);                                             \
        finishSM(PY0, PY1, alY, l_reg, pa0, pa1, pa2, pa3); SBAR();                                                           \
        if ((t) + 1 < NT) { SLOAD_H(Kh, Vh, KBASE((t) + 1)); SBAR(); }                                               \
        pv_tile<VB>(o, vb0, pa0, pa1, pa2, pa3); MASKT(PX0, PX1, (t)); partialSM(PX0, PX1, m_reg, mnX, alX);                                        \
        __syncthreads();                                                                                                      \
        if ((t) + 1 < NT) { VMW(); SWRITE_H(SB); }                                                                          \
        RESC(alX); __syncthreads(); } while (0)
    HALF_STEP(pB0, pB1, mnB, alB, pA0, pA1, alA, 1, 1, 0, 0);
    HALF_STEP(pA0, pA1, mnA, alA, pB0, pB1, alB, 2, 0, 1, 1);
    SBAR(); qkt<1>(pB0, pB1, K_lds, r32, hi, S.qr); SBAR();
    SLOAD_H(nxt.K, nxt.V, 0); SBAR();
    { const char* qb_ = (const char*)nxt.Qb; const unsigned qoff = (tab[r32] * (unsigned)LD + (unsigned)hi * 8u) * 2u;
#pragma unroll
      for (int d0 = 0; d0 < 8; ++d0) S.qr[d0] = *(const bf16x8*)(qb_ + qoff + d0 * 32); }
    SBAR();
    finishSM(pA0, pA1, alA, l_reg, pa0, pa1, pa2, pa3); SBAR();
    pv_tile<0>(o, vb0, pa0, pa1, pa2, pa3);
    MASKT(pB0, pB1, NT - 1); partialSM(pB0, pB1, m_reg, mnB, alB); __syncthreads(); RESC(alB);
    finishSM(pB0, pB1, alB, l_reg, pa0, pa1, pa2, pa3); SBAR(); pv_tile<1>(o, vb0, pa0, pa1, pa2, pa3);
    SBAR(); SEAM_K0();
    if (hi == 0) li_l[r32] = l_reg; asm volatile("s_waitcnt lgkmcnt(0)" ::: "memory");
    float rli[16];
#pragma unroll
    for (int r = 0; r < 16; ++r) rli[r] = __builtin_amdgcn_rcpf(li_l[crow(r, hi)]);
    int lane_e; asm volatile("v_mbcnt_lo_u32_b32 %0, -1, 0\n\tv_mbcnt_hi_u32_b32 %0, -1, %0" : "=v"(lane_e));
    const int r32e = lane_e & 31, hie = lane_e >> 5;
    if (hie == 0) { const unsigned dst = tab[64 + r32e]; typedef float f32x2_t __attribute__((ext_vector_type(2))); *(f32x2_t*)(ML + (size_t)dst * 2) = (f32x2_t){m_reg, l_reg}; }
    const char* pb_ = (const char*)PART;
#pragma unroll
    for (int r = 0; r < 16; ++r) { const unsigned rowoff = tab[64 + crow(r, hie)] * 256u + (unsigned)r32e * 2u;
#pragma unroll
        for (int d0 = 0; d0 < 4; ++d0) { const float v = o[d0][r] * rli[r];
            const float vn = xl_xor(v, lane_e, 1);
            if ((r32e & 1) == 0) *(unsigned*)(pb_ + rowoff + d0 * 64) = cvtpk(v, vn); } }
    __syncthreads();
#undef RESC
#undef KBASE
#undef MASKT
#undef SEAM_K0
#undef HALF_STEP
}
#undef ROW

constexpr int SHM_V2 = KVBLK * 256 * 2, LDS2_K = 2 * SHM_V2, LDS2_WS = LDS2_K + 2 * SHM_K, LDS2_BYTES = LDS2_WS + NW * 64 * 4;
struct Block2Ref { const bf16_t* Q; const bf16_t* K; const bf16_t* V; bf16_t* O; int P0; };
template <int VB>
__device__ __forceinline__ void pv_tile2(f32x16* o, int vb0, bf16x8 pa0, bf16x8 pa1, bf16x8 pa2, bf16x8 pa3) {
#define TRRD(dst, off) asm volatile("ds_read_b64_tr_b16 %0, %1 offset:%2" : "=&v"(dst) : "v"(vb0), "i"(off) : "memory")
#define LDA(d0) do { constexpr int b_ = VB * SHM_V2 + (d0) * 512; TRRD(l0, b_); TRRD(h0, b_ + 4096); TRRD(l1, b_ + 8192); TRRD(h1, b_ + 12288); } while (0)
#define LDB(d0) do { constexpr int b_ = VB * SHM_V2 + (d0) * 512; TRRD(l2, b_ + 16384); TRRD(h2, b_ + 20480); TRRD(l3, b_ + 24576); TRRD(h3, b_ + 28672); } while (0)
#define MMA01(d0) do { \
        o[d0] = __builtin_amdgcn_mfma_f32_32x32x16_bf16(pa0, (bf16x8){l0[0], l0[1], l0[2], l0[3], h0[0], h0[1], h0[2], h0[3]}, o[d0], 0, 0, 0);   \
        o[d0] = __builtin_amdgcn_mfma_f32_32x32x16_bf16(pa1, (bf16x8){l1[0], l1[1], l1[2], l1[3], h1[0], h1[1], h1[2], h1[3]}, o[d0], 0, 0, 0); } while (0)
#define MMA23(d0) do { \
        o[d0] = __builtin_amdgcn_mfma_f32_32x32x16_bf16(pa2, (bf16x8){l2[0], l2[1], l2[2], l2[3], h2[0], h2[1], h2[2], h2[3]}, o[d0], 0, 0, 0);   \
        o[d0] = __builtin_amdgcn_mfma_f32_32x32x16_bf16(pa3, (bf16x8){l3[0], l3[1], l3[2], l3[3], h3[0], h3[1], h3[2], h3[3]}, o[d0], 0, 0, 0); } while (0)
#define W4() do { asm volatile("s_waitcnt lgkmcnt(4)" ::: "memory"); SBAR(); } while (0)
#define W0() do { asm volatile("s_waitcnt lgkmcnt(0)" ::: "memory"); SBAR(); } while (0)
    s16x4 l0, l1, l2, l3, h0, h1, h2, h3;
    LDA(0);
#define STEP(d0) do { LDB(d0); W4(); MMA01(d0); SBAR(); LDA((d0) + 1); W4(); MMA23(d0); SBAR(); } while (0)
    STEP(0); STEP(1); STEP(2); STEP(3); STEP(4); STEP(5); STEP(6);
    LDB(7); W4(); MMA01(7); SBAR(); W0(); MMA23(7);
#undef STEP
#undef W0
#undef W4
#undef MMA23
#undef MMA01
#undef LDB
#undef LDA
#undef TRRD
}
template <int LD, int LDO>
__device__ __forceinline__ void causal_block2(const Block2Ref& cur, char* lds, const int tid) {
    const int wid = __builtin_amdgcn_readfirstlane(tid >> 6), lane = tid & 63, r32 = lane & 31, hi = lane >> 5;
    constexpr int W = 1 << 30;
    const int NT = (cur.P0 + QB - 1) / KVBLK + 1;
    const int qlo = cur.P0 + wid * QBLK, qm = qlo + r32 - 4 * hi;
    char* V_lds = lds; char* K_lds = lds + LDS2_K;
    float* ws = (float*)(lds + LDS2_WS) + wid * 64; float* li_l = ws, * al_l = ws + 32;
    float m_reg = -1e30f, l_reg = 0; f32x16 o[8] = {};
    const unsigned qoff = (unsigned)(r32 * LD + hi * 8) * 2u;
    const int vb0 = (int)(uintptr_t)V_lds + v_rd_base(lane);
    unsigned vofk[2], vofv;
#pragma unroll
    for (int j = 0; j < 2; ++j) { const int row = wid * 8 + j * 4 + (lane >> 4); vofk[j] = (unsigned)(row * LD) * 2u + (unsigned)(((lane & 15) ^ (row & 7)) * 16); }
    { const int kk = wid * 8 + ((lane & 31) >> 2), k = (kk & ~0xC) | ((kk & 4) << 1) | ((kk & 8) >> 1); vofv = (unsigned)(k * LD + (lane >> 5) * 32 + (lane & 3) * 8) * 2u; }
    typedef __attribute__((address_space(3))) unsigned las_u32;
    const unsigned ldsK = (unsigned)(uintptr_t)K_lds + (unsigned)wid * 2048u, ldsV = (unsigned)(uintptr_t)V_lds + (unsigned)wid * 4096u;
    bf16x8 qr[8];
    { const char* qb_ = (const char*)cur.Q + (size_t)(wid * QBLK) * (LD * 2);
#pragma unroll
      for (int d0 = 0; d0 < 8; ++d0) qr[d0] = *(const bf16x8*)(qb_ + qoff + d0 * 32); }
#define DMA2(k0, bf) do { const char* kt_ = (const char*)cur.K + (size_t)(k0) * (LD * 2); const char* vt_ = (const char*)cur.V + (size_t)(k0) * (LD * 2);              \
        _Pragma("unroll") for (int j = 0; j < 2; ++j) __builtin_amdgcn_global_load_lds((const unsigned*)(kt_ + vofk[j]), (las_u32*)(uintptr_t)(ldsK + (bf) * SHM_K + j * 1024), 16, 0, 0);              \
        _Pragma("unroll") for (int j = 0; j < 4; ++j) __builtin_amdgcn_global_load_lds((const unsigned*)(vt_ + j * 128 + vofv), (las_u32*)(uintptr_t)(ldsV + (bf) * SHM_V2 + j * 1024), 16, 0, 0); } while (0)
#define RESC2(a) do { if (__any((a) < 1.f)) { if (hi == 0) al_l[r32] = (a); asm volatile("s_waitcnt lgkmcnt(0)" ::: "memory");              \
                     for (int d_ = 0; d_ < 8; ++d_) for (int r = 0; r < 16; ++r) o[d_][r] *= al_l[crow(r, hi)]; } } while (0)
    DMA2(0, 0); VMW();
    __syncthreads();
    f32x16 p0, p1; float mn, al; bf16x8 pa0, pa1, pa2, pa3;
#define TILE2(t, BUF) do { const int kb_ = (t) * KVBLK;                                                                        \
        if ((t) + 1 < NT) { DMA2(kb_ + KVBLK, 1 - (BUF)); SBAR(); }              \
        qkt<BUF>(p0, p1, K_lds, r32, hi, qr); SBAR();                                                                          \
        if (kb_ + KVBLK - 1 > qlo) mask_tile(p0, p1, qm - kb_, (unsigned)W);                                                   \
        partialSM(p0, p1, m_reg, mn, al); finishSM(p0, p1, al, l_reg, pa0, pa1, pa2, pa3); SBAR();                             \
        RESC2(al); SBAR();                                                                                                     \
        pv_tile2<BUF>(o, vb0, pa0, pa1, pa2, pa3);                                                                             \
        VMW(); __syncthreads(); } while (0)
    for (int t = 0; t < NT; t += 2) { TILE2(t, 0); TILE2(t + 1, 1); }
#undef TILE2
    if (hi == 0) li_l[r32] = l_reg; asm volatile("s_waitcnt lgkmcnt(0)" ::: "memory");
    float rli[16];
#pragma unroll
    for (int r = 0; r < 16; ++r) rli[r] = __builtin_amdgcn_rcpf(li_l[crow(r, hi)]);
    const char* ob_ = (const char*)cur.O + (size_t)(wid * QBLK) * (LDO * 2);
    int lane_e; asm volatile("v_mbcnt_lo_u32_b32 %0, -1, 0\n\tv_mbcnt_hi_u32_b32 %0, -1, %0" : "=v"(lane_e));
    const int r32e = lane_e & 31, hie = lane_e >> 5;
    const unsigned ooff = (unsigned)(4 * hie * LDO + r32e) * 2u;
#pragma unroll
    for (int r = 0; r < 16; ++r) { const char* orp_ = ob_ + (size_t)((r & 3) + 8 * (r >> 2)) * (LDO * 2);
#pragma unroll
        for (int d0 = 0; d0 < 8; ++d0) { const float v = o[d0][r] * rli[r];
            const float vn = xl_xor(v, lane_e, 1);
            if ((r32e & 1) == 0) *(unsigned*)(orp_ + d0 * 64 + ooff) = cvtpk(v, vn); } }
    __syncthreads();
#undef DMA2
#undef RESC2
}

constexpr int SP2_WS = 131072 + 10240;
template <int LD>
__device__ __forceinline__ void sparse2_stage(const bf16_t* Kblk, const bf16_t* Vblk, char* lds, const int tid) {
    const int wid = __builtin_amdgcn_readfirstlane(tid >> 6), lane = tid & 63;
    typedef __attribute__((address_space(3))) unsigned las_u32;
    unsigned vofk[2], vofv;
#pragma unroll
    for (int j = 0; j < 2; ++j) { const int row = wid * 8 + j * 4 + (lane >> 4); vofk[j] = (unsigned)(row * LD) * 2u + (unsigned)(((lane & 15) ^ (row & 7)) * 16); }
    { const int kk = wid * 8 + ((lane & 31) >> 2), k = (kk & ~0xC) | ((kk & 4) << 1) | ((kk & 8) >> 1); vofv = (unsigned)(k * LD + (lane >> 5) * 32 + (lane & 3) * 8) * 2u; }
    const unsigned ldsK = (unsigned)(uintptr_t)lds + (unsigned)wid * 2048u, ldsV = (unsigned)(uintptr_t)lds + 65536u + (unsigned)wid * 2048u;
#pragma unroll
    for (int T = 0; T < 4; ++T) { const char* kt_ = (const char*)Kblk + (size_t)(T * KVBLK) * (LD * 2); const char* vt_ = (const char*)Vblk + (size_t)(T * KVBLK) * (LD * 2);
#pragma unroll
        for (int j = 0; j < 2; ++j) { __builtin_amdgcn_global_load_lds((const unsigned*)(kt_ + vofk[j]), (las_u32*)(uintptr_t)(ldsK + T * SHM_K + j * 1024), 16, 0, 0);
                                      __builtin_amdgcn_global_load_lds((const unsigned*)(vt_ + j * 128 + vofv), (las_u32*)(uintptr_t)(ldsV + T * SHM_V + j * 1024), 16, 0, 0); } }
    asm volatile("s_waitcnt vmcnt(0)" ::: "memory");
}
__device__ __forceinline__ void sparse2_prime(const SparseRef& R, char* lds, const int tid, bf16x8 (&qr)[8], int LD) {
    const int wid = __builtin_amdgcn_readfirstlane(tid >> 6), lane = tid & 63, r32 = lane & 31, hi = lane >> 5;
    float* ws = (float*)(lds + SP2_WS) + wid * 128; unsigned* dst_l = (unsigned*)(ws + 64);
    unsigned qrow, dest; sp_entry(R, wid * QBLK + r32, qrow, dest);
    if (hi == 0) dst_l[r32] = dest;
    const char* qb_ = (const char*)R.Qb; const unsigned qoff = (qrow * (unsigned)LD + (unsigned)hi * 8u) * 2u;
#pragma unroll
    for (int d0 = 0; d0 < 8; ++d0) qr[d0] = *(const bf16x8*)(qb_ + qoff + d0 * 32);
}
template <int LD>
__device__ __forceinline__ void sparse2_wave(const SparseRef& R, const SparseRef& Rn, const bool has_next, const int bank, bf16_t* PART, float* ML, char* lds, const int tid, bf16x8 (&qr)[8]) {
    const int wid = __builtin_amdgcn_readfirstlane(tid >> 6), lane = tid & 63, r32 = lane & 31, hi = lane >> 5;
    constexpr int W = 1 << 30;
    const int qlo = wid * QBLK, qm = qlo + r32 - 4 * hi;
    char* K_lds = lds; char* V_lds = lds + 65536;
    float* ws = (float*)(lds + SP2_WS) + wid * 128; float* li_l = ws, * al_l = ws + 32; unsigned* dst_l = (unsigned*)(ws + 64) + bank * 32; unsigned* ndst_l = (unsigned*)(ws + 64) + (bank ^ 1) * 32;
    const int vb0 = (int)(uintptr_t)V_lds + v_rd_base(lane);
    unsigned nq_ = 0, nd_ = SP_TRASH; if (has_next) sp_entry(Rn, wid * QBLK + r32, nq_, nd_);
    float m_reg = -1e30f, l_reg = 0; f32x16 o[4] = {};
    const bool causal = R.causal != 0;
    f32x16 p0, p1; float mn, al; bf16x8 pa0, pa1, pa2, pa3; bf16x8 qn[8];
#define RESC3(a) do { if (__any((a) < 1.f)) { if (hi == 0) al_l[r32] = (a); asm volatile("s_waitcnt lgkmcnt(0)" ::: "memory");              \
                     for (int d_ = 0; d_ < 4; ++d_) for (int r = 0; r < 16; ++r) o[d_][r] *= al_l[crow(r, hi)]; } } while (0)
#define TILE3(T) do { qkt<T>(p0, p1, K_lds, r32, hi, qr); SBAR();                                                              \
        if (causal && ((T) * KVBLK + KVBLK - 1 > qlo)) mask_tile(p0, p1, qm - (T) * KVBLK, (unsigned)W);                       \
        partialSM(p0, p1, m_reg, mn, al); finishSM(p0, p1, al, l_reg, pa0, pa1, pa2, pa3); SBAR(); RESC3(al); SBAR();          \
        pv_tile<T>(o, vb0, pa0, pa1, pa2, pa3); SBAR(); } while (0)
    TILE3(0); TILE3(1);
    if (has_next) { if (hi == 0) ndst_l[r32] = nd_;
        const char* qb_ = (const char*)Rn.Qb; const unsigned qoff = (nq_ * (unsigned)LD + (unsigned)hi * 8u) * 2u;
#pragma unroll
        for (int d0 = 0; d0 < 8; ++d0) qn[d0] = *(const bf16x8*)(qb_ + qoff + d0 * 32); SBAR(); }
    TILE3(2); TILE3(3);
#undef TILE3
#undef RESC3
    if (hi == 0) li_l[r32] = l_reg; asm volatile("s_waitcnt lgkmcnt(0)" ::: "memory");
    float rli[16];
#pragma unroll
    for (int r = 0; r < 16; ++r) rli[r] = __builtin_amdgcn_rcpf(li_l[crow(r, hi)]);
    int lane_e; asm volatile("v_mbcnt_lo_u32_b32 %0, -1, 0\n\tv_mbcnt_hi_u32_b32 %0, -1, %0" : "=v"(lane_e));
    const int r32e = lane_e & 31, hie = lane_e >> 5;
    if (hie == 0) { const unsigned dst = dst_l[r32e]; typedef float f32x2_t __attribute__((ext_vector_type(2))); *(f32x2_t*)(ML + (size_t)dst * 2) = (f32x2_t){m_reg, l_reg}; }
    const char* pb_ = (const char*)PART;
#pragma unroll
    for (int r = 0; r < 16; ++r) { const unsigned rowoff = dst_l[crow(r, hie)] * 256u + (unsigned)r32e * 2u;
#pragma unroll
        for (int d0 = 0; d0 < 4; ++d0) { const float v = o[d0][r] * rli[r];
            const float vn = xl_xor(v, lane_e, 1);
            if ((r32e & 1) == 0) *(unsigned*)(pb_ + rowoff + d0 * 64) = cvtpk(v, vn); } }
    asm volatile("s_waitcnt lgkmcnt(0)" ::: "memory");
    if (has_next) {
#pragma unroll
        for (int d0 = 0; d0 < 8; ++d0) qr[d0] = qn[d0]; }
}

__device__ __forceinline__ void gate_stage_kmean(const float* km_bh, char* lds, const int tid) {
    const int row = tid >> 3, c0 = (tid & 7) * 2;
#pragma unroll
    for (int c = c0; c < c0 + 2; ++c) { const f32x4 a = *(const f32x4*)(km_bh + row * 128 + c * 8), b = *(const f32x4*)(km_bh + row * 128 + c * 8 + 4);
        u32x4 w = {cvtpk(a[0], a[1]), cvtpk(a[2], a[3]), cvtpk(b[0], b[1]), cvtpk(b[2], b[3])};
        *(u32x4*)(lds + KSWZ(row, c * 16)) = w; }
}
template <int LD>
__device__ __forceinline__ void gate_top3(const bf16_t* Qblk, int nblk, char* lds, const int tid, int& k0, int& k1, int& k2) {
    const int wid = __builtin_amdgcn_readfirstlane(tid >> 6), lane = tid & 63, r32 = lane & 31, hi = lane >> 5;
    bf16x8 qr[8];
    { const char* qb_ = (const char*)Qblk + (size_t)(wid * QBLK) * (LD * 2); const unsigned qoff = (unsigned)(r32 * LD + hi * 8) * 2u;
#pragma unroll
      for (int d0 = 0; d0 < 8; ++d0) qr[d0] = *(const bf16x8*)(qb_ + qoff + d0 * 32); }
    f32x16 p0, p1; qkt<0>(p0, p1, lds, r32, hi, qr);
    const float NEG = -__builtin_inff();
#pragma unroll
    for (int r = 0; r < 16; ++r) { const int bi_ = (r & 3) + 8 * (r >> 2) + 4 * hi; if (bi_ >= nblk) p0[r] = NEG; if (bi_ + 32 >= nblk) p1[r] = NEG; }
    int pick[3];
#pragma unroll
    for (int t = 0; t < 3; ++t) {
        float bv = NEG; int bidx = 64;
#pragma unroll
        for (int r = 0; r < 16; ++r) { const int bi_ = (r & 3) + 8 * (r >> 2) + 4 * hi; if (p0[r] > bv) { bv = p0[r]; bidx = bi_; } }
#pragma unroll
        for (int r = 0; r < 16; ++r) { const int bi_ = 32 + (r & 3) + 8 * (r >> 2) + 4 * hi; if (p1[r] > bv) { bv = p1[r]; bidx = bi_; } }
        auto rv = __builtin_amdgcn_permlane32_swap(__float_as_uint(bv), __float_as_uint(bv), false, false);
        auto ri = __builtin_amdgcn_permlane32_swap((unsigned)bidx, (unsigned)bidx, false, false);
        const float va = __uint_as_float(rv[0]), vb = __uint_as_float(rv[1]); const int ia = (int)ri[0], ib = (int)ri[1];
        const bool takea = (va > vb) || (va == vb && ia < ib);
        const float wv = takea ? va : vb; const int wi = (wv > NEG) ? (takea ? ia : ib) : 64;
        pick[t] = wi;
#pragma unroll
        for (int r = 0; r < 16; ++r) { const int bi_ = (r & 3) + 8 * (r >> 2) + 4 * hi; if (bi_ == wi) p0[r] = NEG; if (bi_ + 32 == wi) p1[r] = NEG; }
    }
    k0 = pick[0]; k1 = pick[1]; k2 = pick[2];
}
#undef VMW
#undef VMWN
#undef SLOAD_H
#undef SWRITE_HK
#undef SWRITE_HV
#undef SWRITE_H
#undef KSWZ
#undef SBAR
}
#define GAS __attribute__((address_space(1)))
#define LAS __attribute__((address_space(3)))
typedef unsigned short bf16;
typedef unsigned v4u __attribute__((ext_vector_type(4)));
typedef float f32x4 __attribute__((ext_vector_type(4)));
typedef short bf16x8 __attribute__((ext_vector_type(8)));
typedef GAS unsigned gu32;
typedef GAS unsigned long long gu64;
#define RLX_AGENT __ATOMIC_RELAXED, __HIP_MEMORY_SCOPE_AGENT
#define LDS_WAIT() asm volatile("s_waitcnt lgkmcnt(0)" ::: "memory")
#define VM_WAIT() asm volatile("s_waitcnt vmcnt(0)" ::: "memory")
__device__ __forceinline__ unsigned long long rt() { return __builtin_amdgcn_s_memrealtime(); }
__device__ __forceinline__ unsigned f2bf(float f) { unsigned u = __builtin_bit_cast(unsigned, f); return (u + 0x7fffu + ((u >> 16) & 1u)) >> 16; }
__device__ __forceinline__ unsigned pk2(float lo, float hi) { return f2bf(lo) | (f2bf(hi) << 16); }
#define XB_TMO      128
#define XB_XCNT(j)  (256  + 64 * (j))
#define XB_XSUB(j)  (1280 + 64 * (j))
#define XB_XGEN(j)  (2304 + 64 * (j))
#define XB_TOP      3328
#define XB_TOPGEN   3392
#define XCD_BAR_WORDS 3456
#define XB_SPIN_CAP (1u << 18)

__device__ __forceinline__ unsigned xb_ld(unsigned* p)              { return __hip_atomic_load(p, __ATOMIC_RELAXED, __HIP_MEMORY_SCOPE_AGENT); }
__device__ __forceinline__ unsigned xb_add(unsigned* p, unsigned v) { return __hip_atomic_fetch_add(p, v, __ATOMIC_RELAXED, __HIP_MEMORY_SCOPE_AGENT); }
__device__ __forceinline__ unsigned xb_xcc_id() { return (unsigned)__builtin_amdgcn_s_getreg((3 << 11) | 20) & 0xFu; }
#define XB_SPIN(cond, bar) do { unsigned _sp = 0; while (cond) { __builtin_amdgcn_s_sleep(1); \
    if ((++_sp & 255u) == 0u) { if (xb_ld(&(bar)[XB_TMO])) break; if (_sp > XB_SPIN_CAP) { atomicAdd(&(bar)[XB_TMO], 1u); break; } } } } while (0)

struct XcdBarrier {
    unsigned* bar; unsigned x; unsigned G;
    volatile LAS unsigned* st;
};

__device__ __forceinline__ XcdBarrier xcd_barrier_post(unsigned* bar, volatile LAS unsigned* st, const bool leader) {
    XcdBarrier b; b.bar = bar; b.x = xb_xcc_id(); b.st = st; b.G = gridDim.x * gridDim.y * gridDim.z;
    if (leader) (void)xb_add(&bar[XB_XCNT(b.x)], 1u);
    return b;
}
__device__ __forceinline__ void xcd_barrier_complete(unsigned* bar, unsigned x, unsigned G, unsigned& nloc, unsigned& nx) {
    unsigned sum, cnt, mine, sp = 0u;
    for (;;) {
        sum = 0u; cnt = 0u; mine = 0u;
#pragma unroll
        for (unsigned j = 0; j < 16; ++j) { const unsigned c = xb_ld(&bar[XB_XCNT(j)]); sum += c; cnt += (c > 0u) ? 1u : 0u; mine = (j == x) ? c : mine; }
        if (sum == G) break;
        __builtin_amdgcn_s_sleep(1);
        if ((++sp & 255u) == 0u) { if (xb_ld(&bar[XB_TMO])) break; if (sp > XB_SPIN_CAP) { atomicAdd(&bar[XB_TMO], 1u); break; } }
    }
    nloc = mine > 0u ? mine : 1u; nx = cnt > 0u ? cnt : 1u;
}

__device__ __forceinline__ void xcd_barrier(const XcdBarrier& b, const bool leader) {
    asm volatile("s_waitcnt vmcnt(0)" ::: "memory");
    __syncthreads();
    if (leader) {
        unsigned* bar = b.bar;
        __builtin_amdgcn_s_waitcnt(0);
        unsigned nloc = b.st[0], nx = b.st[1];
        if (nloc == 0u) { xcd_barrier_complete(bar, b.x, b.G, nloc, nx); b.st[0] = nloc; b.st[1] = nx; }
        const unsigned old = xb_add(&bar[XB_XSUB(b.x)], 1u);
        const unsigned gen = old / nloc;
        if (old + 1u == (gen + 1u) * nloc) {
            __builtin_amdgcn_fence(__ATOMIC_RELEASE, "agent");
            asm volatile("s_waitcnt vmcnt(0)" ::: "memory");
            const unsigned og = xb_add(&bar[XB_TOP], 1u);
            const unsigned tg = og / nx;
            if (og + 1u == (tg + 1u) * nx) xb_add(&bar[XB_TOPGEN], 1u);
            else XB_SPIN(xb_ld(&bar[XB_TOPGEN]) == tg, bar);
            __builtin_amdgcn_fence(__ATOMIC_ACQUIRE, "agent");
            xb_add(&bar[XB_XGEN(b.x)], 1u);
            asm volatile("s_waitcnt vmcnt(0)" ::: "memory");
        } else {
            XB_SPIN(xb_ld(&bar[XB_XGEN(b.x)]) == gen, bar);
            __builtin_amdgcn_fence(__ATOMIC_ACQUIRE, "agent");
            asm volatile("s_waitcnt vmcnt(0)" ::: "memory");
        }
    }
    __syncthreads();
}

#ifndef NLAYERS_RUN
#define NLAYERS_RUN 4
#endif
constexpr int NWAVES = 8, NTHR = 512;
constexpr int BATCH = 2, SEQ = 16384, DM = 2048, DEPTH = 4;
constexpr int M = BATCH * SEQ;
constexpr int EV_IN = 6144, OD_IN = 2560, FFH = 5632, FF2 = 11264, NMOD = 12288;
constexpr float RMS_EPS = 1e-6f, SUBLN_EPS = 1e-5f;
#ifndef MK_PER_PHASE
#define MK_PER_PHASE 0
#endif

constexpr size_t MiB = 1u << 20;
constexpr size_t WS_CTL = 0, CTL_ZERO_BYTES = 3 * MiB;
constexpr size_t WS_SS = 1 * MiB;
constexpr size_t WS_MOD = 3 * MiB;
constexpr size_t WS_KM = 4 * MiB;
constexpr size_t WS_BIAS = 5 * MiB;
constexpr size_t WS_ROPE = 6 * MiB;
constexpr size_t WS_W = 18 * MiB;
constexpr size_t W_EVIN = WS_W;
constexpr size_t W_EVOUT = W_EVIN + 48 * MiB;
constexpr size_t W_ODIN = W_EVOUT + 16 * MiB;
constexpr size_t W_ODOUT = W_ODIN + 20 * MiB;
constexpr size_t W_FFIN = W_ODOUT + 16 * MiB;
constexpr size_t W_FFOUT = W_FFIN + 176 * MiB;
constexpr size_t WS_XH = W_FFOUT + 88 * MiB;
constexpr size_t WS_PROJ = WS_XH + 128 * MiB;
constexpr size_t WS_OT = WS_PROJ + 384 * MiB;
constexpr size_t WS_Y = WS_OT + 128 * MiB;
constexpr size_t WS_PART = WS_Y + 128 * MiB;
constexpr size_t WS_ML = WS_PART + 257 * MiB;
constexpr size_t WS_LIST = WS_ML + 9 * MiB;
constexpr size_t WS_SSP = WS_LIST + 64 * MiB;
constexpr size_t WS_END = WS_SSP + 10 * MiB;
constexpr int CW_BAR = 4096;
constexpr int CW_CNT = 16384;

constexpr int RING_OFF = 0, RING_BYTES = 131072;
constexpr int LDSCTL_OFF = RING_BYTES, MISC_OFF = LDSCTL_OFF + 320;
constexpr int LDS_BYTES = 147456;

struct Args {
    const float* x; const float* c; const float* ada_w; const float* ada_b; const float* ab_w_in; const float* ab_w_out; const float* diff_lambda; const float* diff_subln;
    const float* swa_w_in; const float* swa_b_in; const float* swa_w_out; const float* swa_b_out; const float* swa_sinks; const float* ffn_w_in; const float* ffn_w_out; const float* final_norm;
    float* out; unsigned char* ws;
    float invf128[64]; float invf64[32]; float lam_init[4];
    int ph_lo, ph_hi;
};
static_assert(sizeof(Args) % 8 == 0, "no tail padding");

__device__ __forceinline__ float wave_sum(float v) {
    const int l = xl_lane();
#pragma unroll
    for (int o = 1; o < 64; o <<= 1) v += xl_xor(v, l, o);
    return v;
}

__device__ __forceinline__ unsigned pk2h(float lo, float hi) { typedef _Float16 h2 __attribute__((ext_vector_type(2))); h2 v = {(_Float16)lo, (_Float16)hi}; return __builtin_bit_cast(unsigned, v); }
__device__ __forceinline__ void p0_load(const float* W, int N, int item, int lane, f32x4 (&v)[8]) {
    const int nblk = N / 32, kb = item / nblk, nb = item % nblk, k0 = 64 * kb, n0 = 32 * nb;
#pragma unroll
    for (int i = 0; i < 8; ++i) v[i] = *(const GAS f32x4*)(W + (size_t)(k0 + 8 * i + (lane >> 3)) * N + n0 + 4 * (lane & 7));
}
template <int PERM_KIND, bool F16, bool ACC>
__device__ __forceinline__ void p0_finish(const f32x4 (&v)[8], int K, int N, bf16* WT, LAS float* scr, int item, int lane, const float* sh0, f32x4* pb) {
    const int nblk = N / 32, kb = item / nblk, nb = item % nblk, k0 = 64 * kb, n0 = 32 * nb;
#pragma unroll
    for (int i = 0; i < 8; ++i) { LAS float* d = scr + (8 * i + (lane >> 3)) * 33 + 4 * (lane & 7); d[0] = v[i].x; d[1] = v[i].y; d[2] = v[i].z; d[3] = v[i].w; }
    if constexpr (ACC) {
#pragma unroll
        for (int i = 0; i < 8; ++i) { const int k = k0 + 8 * i + (lane >> 3); pb[0] += v[i] * sh0[k]; pb[1] += v[i] * sh0[NMOD + k]; } }
    LDS_WAIT(); asm volatile("" ::: "memory");
    const int c = lane & 7;
#pragma unroll
    for (int j = 0; j < 4; ++j) { const int n = (lane >> 3) + 8 * j; const LAS float* s = scr + (8 * c) * 33 + n;
        v4u o; if constexpr (F16) { o.x = pk2h(s[0 * 33], s[1 * 33]); o.y = pk2h(s[2 * 33], s[3 * 33]); o.z = pk2h(s[4 * 33], s[5 * 33]); o.w = pk2h(s[6 * 33], s[7 * 33]); }
        else { o.x = pk2(s[0 * 33], s[1 * 33]); o.y = pk2(s[2 * 33], s[3 * 33]); o.z = pk2(s[4 * 33], s[5 * 33]); o.w = pk2(s[6 * 33], s[7 * 33]); }
        const int nn = n0 + n;
        const int dst = PERM_KIND == 1 ? pg8::perm_even_in(nn) : PERM_KIND == 2 ? pg8::perm_odd_in(nn) : PERM_KIND == 3 ? pg8::perm_ffn_in(nn) : nn;
        *(GAS v4u*)(WT + (size_t)dst * K + k0 + 8 * c) = o; }
    LDS_WAIT(); asm volatile("" ::: "memory");
}
template <int PERM_KIND, bool F16, bool ACC>
__device__ __forceinline__ void p0_run(const float* W, int K, int N, bf16* WT, LAS float* scr, int lane, int first, int step, int cnt, const float* sh0 = nullptr, f32x4* pb = nullptr) {
    if (cnt <= 0) return;
    f32x4 va[8], vb[8];
    p0_load(W, N, first, lane, va);
    for (int i = 0; i < cnt; i += 2) {
        if (i + 1 < cnt) p0_load(W, N, first + (i + 1) * step, lane, vb);
        p0_finish<PERM_KIND, F16, ACC>(va, K, N, WT, scr, first + i * step, lane, sh0, pb);
        if (i + 1 < cnt) { if (i + 2 < cnt) p0_load(W, N, first + (i + 2) * step, lane, va);
            p0_finish<PERM_KIND, F16, ACC>(vb, K, N, WT, scr, first + (i + 1) * step, lane, sh0, pb); }
    }
}
__device__ __forceinline__ void dsincos(double x, double& s, double& c) {
    const double k = __builtin_rint(x * 0.63661977236758134308);
    double r = __builtin_fma(-k, 1.57079632679489655800e+00, x); r = __builtin_fma(-k, 6.12323399573676603587e-17, r);
    const double z = r * r;
    double ps = -7.6471637318198164759e-13;
    ps = ps * z + 1.6059043836821614599e-10;
    ps = ps * z - 2.5052108385441718775e-08;
    ps = ps * z + 2.7557319223985890653e-06;
    ps = ps * z - 1.9841269841269841270e-04;
    ps = ps * z + 8.3333333333333333333e-03;
    ps = ps * z - 1.6666666666666666667e-01;
    const double sr = r + r * z * ps;
    double pc = 4.7794773323873852974e-14;
    pc = pc * z - 1.1470745597729724714e-11;
    pc = pc * z + 2.0876756987868098979e-09;
    pc = pc * z - 2.7557319223985890653e-07;
    pc = pc * z + 2.4801587301587301587e-05;
    pc = pc * z - 1.3888888888888888889e-03;
    pc = pc * z + 4.1666666666666666667e-02;
    pc = pc * z - 0.5;
    const double cr = 1.0 + z * pc;
    const int q = ((int)k) & 3;
    s = (q == 0) ? sr : (q == 1) ? cr : (q == 2) ? -sr : -cr;
    c = (q == 0) ? cr : (q == 1) ? -sr : (q == 2) ? -cr : sr;
}

__device__ __forceinline__ void first_norm_phase(const float* xin, const float* sc0, bf16* xa, float* ss, int gw, int NGW, int lane) {
    for (int m0 = gw * 2; m0 < M; m0 += NGW * 2) {
        f32x4 v[2][8]; float s[2];
#pragma unroll
        for (int q = 0; q < 2; ++q) { const GAS f32x4* xr = (const GAS f32x4*)(xin + (size_t)(m0 + q) * DM) + lane;
#pragma unroll
            for (int j = 0; j < 8; ++j) v[q][j] = xr[64 * j]; }
#pragma unroll
        for (int q = 0; q < 2; ++q) { float a = 0.f;
#pragma unroll
            for (int j = 0; j < 8; ++j) a += (v[q][j].x * v[q][j].x + v[q][j].y * v[q][j].y) + (v[q][j].z * v[q][j].z + v[q][j].w * v[q][j].w);
            s[q] = a; }
        s[0] = wave_sum(s[0]); s[1] = wave_sum(s[1]);
#pragma unroll
        for (int q = 0; q < 2; ++q) { const int m = m0 + q; if (lane < 8) ss[(size_t)lane * M + m] = lane == 0 ? s[q] : 0.f;
            const GAS f32x4* sc = (const GAS f32x4*)(sc0 + ((m >= SEQ) ? NMOD : 0)) + lane;
            GAS unsigned long long* o8 = (GAS unsigned long long*)(xa + (size_t)m * DM) + lane;
#pragma unroll
            for (int j = 0; j < 8; ++j) { f32x4 sg = sc[64 * j] + 1.0f;
#pragma unroll
                for (int e = 0; e < 4; ++e) sg[e] = __builtin_fabsf(sg[e]) < 1e-20f ? __builtin_copysignf(1e-20f, sg[e]) : sg[e];
                const f32x4 h = v[q][j] * sg;
                o8[64 * j] = pg8::XA_F16 ? ((unsigned long long)pk2h(h.x, h.y) | ((unsigned long long)pk2h(h.z, h.w) << 32)) : ((unsigned long long)pk2(h.x, h.y) | ((unsigned long long)pk2(h.z, h.w) << 32)); } }
    }
}
__device__ __forceinline__ void final_norm_phase(const bf16* xh, const float* ss, const float* w, float* out, int gw, int NGW, int lane) {
    const GAS f32x4* wr = (const GAS f32x4*)w + lane;
    typedef _Float16 h4 __attribute__((ext_vector_type(4)));
    for (int m0 = gw * 2; m0 < M; m0 += NGW * 2) {
        unsigned long long xv[2][8];
#pragma unroll
        for (int q = 0; q < 2; ++q) { const GAS unsigned long long* xr = (const GAS unsigned long long*)(xh + (size_t)(m0 + q) * DM) + lane;
#pragma unroll
            for (int j = 0; j < 8; ++j) xv[q][j] = xr[64 * j]; }
#pragma unroll
        for (int q = 0; q < 2; ++q) { float sq = ss[m0 + q];
#pragma unroll
            for (int j = 1; j < 8; ++j) sq += ss[(size_t)j * M + m0 + q];
            const float rstd = 1.0f / sqrtf(sq * (1.f / DM) + RMS_EPS);
            GAS f32x4* o = (GAS f32x4*)(out + (size_t)(m0 + q) * DM) + lane;
#pragma unroll
            for (int j = 0; j < 8; ++j) { const h4 hv = __builtin_bit_cast(h4, xv[q][j]);
                const f32x4 v = {(float)hv[0], (float)hv[1], (float)hv[2], (float)hv[3]}; o[64 * j] = v * rstd * wr[64 * j]; } }
    }
}
__device__ __forceinline__ float gemv2_chunk(const float* W, int N, int ch, const LAS float* cond, LAS float* red, int tid) {
    const int lane = tid & 63, wave = __builtin_amdgcn_readfirstlane(tid >> 6), cg = lane & 15, kr = lane >> 4;
    const float* wp = W + (size_t)(256 * wave + kr) * N + ch * 64 + cg * 4;
    f32x4 a0 = {0.f, 0.f, 0.f, 0.f}, a1 = {0.f, 0.f, 0.f, 0.f};
#pragma unroll 8
    for (int i = 0; i < 64; ++i) { const f32x4 w = *(const GAS f32x4*)(wp + (size_t)(4 * i) * N); const int k = 256 * wave + 4 * i + kr;
        a0 += w * cond[k]; a1 += w * cond[DM + k]; }
    { const int l = xl_lane();
#pragma unroll
    for (int e = 0; e < 4; ++e) { a0[e] += xl_xor(a0[e], l, 16); a0[e] += xl_xor(a0[e], l, 32); a1[e] += xl_xor(a1[e], l, 16); a1[e] += xl_xor(a1[e], l, 32); } }
    if (lane < 16) { *(LAS f32x4*)(red + (wave * 2 + 0) * 64 + cg * 4) = a0; *(LAS f32x4*)(red + (wave * 2 + 1) * 64 + cg * 4) = a1; }
    __syncthreads();
    float s = 0.f;
    if (tid < 128) { const int b = tid >> 6, col = tid & 63;
#pragma unroll
        for (int w = 0; w < 8; ++w) s += red[(w * 2 + b) * 64 + col]; }
    __syncthreads();
    return s;
}
__device__ __forceinline__ void kmean_phase(const bf16* proj, float* km, LAS unsigned char* lds, int vcu, int G, int tid) {
    const int wave = tid >> 6, lane = tid & 63;
    LAS float* red = (LAS float*)lds;
    for (int u = vcu; u < BATCH * 64 * 2; u += G) {
        const int half = u & 1, j = (u >> 1) & 63, b = u >> 7;
        const bf16* src = proj + ((size_t)(b * SEQ + j * 256)) * EV_IN + 1024 + half * 512 + lane * 8;
        float a[8];
#pragma unroll
        for (int e = 0; e < 8; ++e) a[e] = 0.f;
#pragma unroll 8
        for (int r = wave; r < 256; r += 8) { const v4u w = *(const GAS v4u*)(src + (size_t)r * EV_IN);
            a[0] += __uint_as_float(w.x << 16); a[1] += __uint_as_float(w.x & 0xffff0000u); a[2] += __uint_as_float(w.y << 16); a[3] += __uint_as_float(w.y & 0xffff0000u);
            a[4] += __uint_as_float(w.z << 16); a[5] += __uint_as_float(w.z & 0xffff0000u); a[6] += __uint_as_float(w.w << 16); a[7] += __uint_as_float(w.w & 0xffff0000u); }
#pragma unroll
        for (int e = 0; e < 8; ++e) red[wave * 512 + lane * 8 + e] = a[e];
        __syncthreads();
        { const int col = tid; float s = 0.f;
#pragma unroll
          for (int w = 0; w < 8; ++w) s += red[w * 512 + col];
          const int cc = half * 512 + col, h = cc >> 7, d = cc & 127;
          km[(((size_t)(b * 8 + h)) * 64 + j) * 128 + d] = s * (1.0f / 256.0f); }
        __syncthreads();
    }
}
__device__ __forceinline__ void gate_phase(const bf16* proj, const float* km, unsigned* cnt, unsigned* list, LAS unsigned char* lds, unsigned char* lds_raw, int vcu, int G, int tid) {
    LAS int* cntl = (LAS int*)(lds + 40960); LAS int* basel = cntl + 64;
    const int lane = tid & 63, r32 = lane & 31, hi = lane >> 5, wid = tid >> 6;
    for (int u = vcu; u < BATCH * 8 * 64; u += G) {
        const int i = ((u >> 8) & 1) ? 63 - (u & 63) : (u & 63), h = (u >> 6) & 7, b = u >> 9;
        if (i == 0) continue;
        if (tid < 64) cntl[tid] = 0;
        att::gate_stage_kmean(km + ((size_t)(b * 8 + h) * 64) * 128, (char*)lds_raw, tid);
        __syncthreads();
        int pk0, pk1, pk2; att::gate_top3<EV_IN>(proj + ((size_t)b * SEQ + i * 256) * EV_IN + h * 128, i, (char*)lds_raw, tid, pk0, pk1, pk2);
        const int qi = wid * 32 + r32;
        int sl0 = 0, sl1 = 0, sl2 = 0;
        if (hi == 0) { if (pk0 < 64) sl0 = __hip_atomic_fetch_add(cntl + pk0, 1, __ATOMIC_RELAXED, __HIP_MEMORY_SCOPE_WORKGROUP);
                       if (pk1 < 64) sl1 = __hip_atomic_fetch_add(cntl + pk1, 1, __ATOMIC_RELAXED, __HIP_MEMORY_SCOPE_WORKGROUP);
                       if (pk2 < 64) sl2 = __hip_atomic_fetch_add(cntl + pk2, 1, __ATOMIC_RELAXED, __HIP_MEMORY_SCOPE_WORKGROUP); }
        __syncthreads();
        if (tid < i) { const int c = cntl[tid]; basel[tid] = c > 0 ? (int)atomicAdd(cnt + (b * 8 + h) * 64 + tid, (unsigned)c) : 0; }
        __syncthreads();
        if (hi == 0) { const unsigned ent = (unsigned)(i * 256 + qi); const size_t lb = (size_t)((b * 8 + h) * 64) * 16384;
            if (pk0 < 64) list[lb + (size_t)pk0 * 16384 + basel[pk0] + sl0] = ent;
            if (pk1 < 64) list[lb + (size_t)pk1 * 16384 + basel[pk1] + sl1] = ent | (1u << 14);
            if (pk2 < 64) list[lb + (size_t)pk2 * 16384 + basel[pk2] + sl2] = ent | (2u << 14); }
        __syncthreads();
    }
}
__device__ __forceinline__ void diff_combine_phase(const bf16* ot, bf16* y, const float* lamv, const float* subln, float lam_init, int gw, int NGW, int lane) {
    float d1 = lamv[lane] * lamv[128 + lane] + lamv[64 + lane] * lamv[192 + lane];
    float d2 = lamv[256 + lane] * lamv[384 + lane] + lamv[320 + lane] * lamv[448 + lane];
    d1 = wave_sum(d1); d2 = wave_sum(d2);
    const float lam = expf(d1) - expf(d2) + lam_init;
    const f32x4 sw = *(const GAS f32x4*)(subln + 4 * lane);
    const float post = 1.0f - lam_init;
    for (int it0 = gw * 8; it0 < M * 4; it0 += NGW * 8) {
        unsigned long long w1[8], w2[8];
#pragma unroll
        for (int q = 0; q < 8; ++q) { const int it = it0 + q; const int hb = it & 3; const size_t row = (size_t)(it >> 2); const bf16* p = ot + row * DM + hb * 512 + 4 * lane;
            w1[q] = *(const GAS unsigned long long*)p; w2[q] = *(const GAS unsigned long long*)(p + 256); }
        f32x4 yb[8]; float ss[8];
#pragma unroll
        for (int q = 0; q < 8; ++q) { f32x4 a, b;
            a.x = __uint_as_float((unsigned)w1[q] << 16); a.y = __uint_as_float((unsigned)w1[q] & 0xffff0000u); a.z = __uint_as_float((unsigned)(w1[q] >> 32) << 16); a.w = __uint_as_float((unsigned)(w1[q] >> 32) & 0xffff0000u);
            b.x = __uint_as_float((unsigned)w2[q] << 16); b.y = __uint_as_float((unsigned)w2[q] & 0xffff0000u); b.z = __uint_as_float((unsigned)(w2[q] >> 32) << 16); b.w = __uint_as_float((unsigned)(w2[q] >> 32) & 0xffff0000u);
            yb[q] = a - b * lam; ss[q] = (yb[q].x * yb[q].x + yb[q].y * yb[q].y) + (yb[q].z * yb[q].z + yb[q].w * yb[q].w); }
        { const int l = xl_lane();
#pragma unroll
          for (int o = 1; o < 64; o <<= 1) {
#pragma unroll
            for (int q = 0; q < 8; ++q) ss[q] += xl_xor(ss[q], l, o); } }
#pragma unroll
        for (int q = 0; q < 8; ++q) { const int it = it0 + q; const int hb = it & 3; const size_t row = (size_t)(it >> 2);
            const float rstd = 1.0f / sqrtf(ss[q] * (1.0f / 256.0f) + SUBLN_EPS);
            const f32x4 o = yb[q] * rstd * sw * post;
            *(GAS unsigned long long*)(y + row * DM + 1024 + hb * 256 + 4 * lane) = (unsigned long long)pk2(o.x, o.y) | ((unsigned long long)pk2(o.z, o.w) << 32); }
    }
}
__device__ __forceinline__ void moba_combine_phase(const bf16* part, const float* ml, bf16* y, int gw, int NGW, int lane) {
    constexpr float C2 = 0.08838834764831845f * 1.4426950408889634f;
    const int sub = lane >> 5, c4 = (lane & 31) * 4;
    constexpr int U = 4;
    for (int it0 = gw * U; it0 < M * 8 / 2; it0 += NGW * U) {
        f32x4 ml01[U], ml23[U]; unsigned long long pv4[U][4];
#pragma unroll
        for (int q = 0; q < U; ++q) { const int item = (it0 + q) * 2 + sub;
            ml01[q] = *(const GAS f32x4*)(ml + (size_t)item * 8); ml23[q] = *(const GAS f32x4*)(ml + (size_t)item * 8 + 4);
            const bf16* p = part + (size_t)item * 512 + c4;
#pragma unroll
            for (int s = 0; s < 4; ++s) pv4[q][s] = *(const GAS unsigned long long*)(p + s * 128); }
#pragma unroll
        for (int q = 0; q < U; ++q) { const int item = (it0 + q) * 2 + sub; const int row = item >> 3, h = item & 7; const int nv = min((row & (SEQ - 1)) >> 8, 3);
            const float NEG = -__builtin_inff();
            const float m0 = nv > 0 ? ml01[q].x : NEG, m1 = nv > 1 ? ml01[q].z : NEG, m2 = nv > 2 ? ml23[q].x : NEG, m3 = ml23[q].z;
            const float mx = fmaxf(fmaxf(m0, m1), fmaxf(m2, m3));
            const float w0 = nv > 0 ? ml01[q].y * __builtin_amdgcn_exp2f((m0 - mx) * C2) : 0.f, w1 = nv > 1 ? ml01[q].w * __builtin_amdgcn_exp2f((m1 - mx) * C2) : 0.f;
            const float w2 = nv > 2 ? ml23[q].y * __builtin_amdgcn_exp2f((m2 - mx) * C2) : 0.f, w3 = ml23[q].w * __builtin_amdgcn_exp2f((m3 - mx) * C2);
            const float rw = 1.0f / ((w0 + w1) + (w2 + w3));
            f32x4 acc = {0.f, 0.f, 0.f, 0.f};
#pragma unroll
            for (int s = 0; s < 4; ++s) { const float w = s == 0 ? w0 : s == 1 ? w1 : s == 2 ? w2 : w3; const bool ok = (s == 3) || (s < nv); const unsigned long long v = pv4[q][s];
                const f32x4 t = {w * __uint_as_float((unsigned)v << 16), w * __uint_as_float((unsigned)v & 0xffff0000u), w * __uint_as_float((unsigned)(v >> 32) << 16), w * __uint_as_float((unsigned)(v >> 32) & 0xffff0000u)};
                acc.x += ok ? t.x : 0.f; acc.y += ok ? t.y : 0.f; acc.z += ok ? t.z : 0.f; acc.w += ok ? t.w : 0.f; }
            acc = acc * rw;
            *(GAS unsigned long long*)(y + (size_t)row * DM + h * 128 + c4) = (unsigned long long)pk2(acc.x, acc.y) | ((unsigned long long)pk2(acc.z, acc.w) << 32); }
    }
}

namespace swa {
typedef short bf16x8 __attribute__((ext_vector_type(8)));
typedef float f32x16 __attribute__((ext_vector_type(16)));
constexpr int KS_STRIDE = 144, VT_STRIDE = 528;
constexpr int OFF_K = 0, OFF_VT = 256 * KS_STRIDE, OFF_L = OFF_VT + 64 * VT_STRIDE, OFF_O = OFF_L + 8 * 32 * 4, O_STRIDE = 144, LDS_END = OFF_O + 8 * 32 * O_STRIDE;
static_assert(LDS_END <= RING_BYTES, "swa LDS");
__device__ __forceinline__ int crow(int r, int hi) { return (r & 3) + 8 * (r >> 2) + 4 * hi; }
__device__ __forceinline__ unsigned cvtpk(float lo, float hi) { unsigned r; asm volatile("v_cvt_pk_bf16_f32 %0, %1, %2" : "=v"(r) : "v"(lo), "v"(hi)); return r; }
__device__ __forceinline__ void phase(const bf16* proj, bf16* y, const float* sinks, LAS unsigned char* lds, int vcu, int G, int tid) {
    const int wave = __builtin_amdgcn_readfirstlane(tid >> 6), lane = tid & 63, r32 = lane & 31, hi = lane >> 5;
    constexpr float C2 = 0.125f * 1.4426950408889634f;
    for (int u = vcu; u < BATCH * 4 * 128; u += G) {
        const int bi = u & 127, kvh = (u >> 7) & 3, b = u >> 9;
        const int hq = kvh * 8 + wave;
        bf16x8 qra[4][4];
#pragma unroll
        for (int sb = 0; sb < 4; ++sb)
#pragma unroll
            for (int d0 = 0; d0 < 4; ++d0) qra[sb][d0] = *(const GAS bf16x8*)(proj + ((size_t)b * SEQ + bi * 128 + sb * 32 + r32) * OD_IN + hq * 64 + d0 * 16 + hi * 8);
        v4u kwv[4], vwv[4];
#pragma unroll
        for (int i = 0; i < 4; ++i) { const int c = tid + NTHR * i, kk = c >> 3, ch = c & 7; const int kpos = (bi - 1) * 128 + kk;
            kwv[i] = (v4u){0u, 0u, 0u, 0u}; vwv[i] = (v4u){0u, 0u, 0u, 0u};
            if (kpos >= 0) { const bf16* src = proj + ((size_t)b * SEQ + kpos) * OD_IN + 2048 + kvh * 64 + ch * 8; kwv[i] = *(const GAS v4u*)src; vwv[i] = *(const GAS v4u*)(src + 256); } }
#pragma unroll
        for (int i = 0; i < 4; ++i) { const int c = tid + NTHR * i, kk = c >> 3, ch = c & 7; const v4u kw = kwv[i], vw = vwv[i];
            *(LAS v4u*)(lds + OFF_K + kk * KS_STRIDE + ch * 16) = kw;
            LAS unsigned short* vt = (LAS unsigned short*)(lds + OFF_VT + (ch * 8) * VT_STRIDE + kk * 2);
            vt[0 * (VT_STRIDE / 2)] = (unsigned short)(vw.x & 0xffffu); vt[1 * (VT_STRIDE / 2)] = (unsigned short)(vw.x >> 16);
            vt[2 * (VT_STRIDE / 2)] = (unsigned short)(vw.y & 0xffffu); vt[3 * (VT_STRIDE / 2)] = (unsigned short)(vw.y >> 16);
            vt[4 * (VT_STRIDE / 2)] = (unsigned short)(vw.z & 0xffffu); vt[5 * (VT_STRIDE / 2)] = (unsigned short)(vw.z >> 16);
            vt[6 * (VT_STRIDE / 2)] = (unsigned short)(vw.w & 0xffffu); vt[7 * (VT_STRIDE / 2)] = (unsigned short)(vw.w >> 16); }
        __syncthreads();
        const float sinkl = sinks[hq] * 1.4426950408889634f;
        LAS float* Lw = (LAS float*)(lds + OFF_L) + wave * 32;
        LAS unsigned char* Ow = lds + OFF_O + wave * 32 * O_STRIDE;
#pragma unroll
        for (int sb = 0; sb < 4; ++sb) {
            const size_t qrow = (size_t)b * SEQ + bi * 128 + sb * 32;
            bf16x8 qr[4];
#pragma unroll
            for (int d0 = 0; d0 < 4; ++d0) qr[d0] = qra[sb][d0];
            const int t0 = sb >> 1;
            f32x16 p[3][2];
#pragma unroll
            for (int tt = 0; tt < 3; ++tt)
#pragma unroll
                for (int hf = 0; hf < 2; ++hf) { f32x16 a = {};
                    const LAS unsigned char* kb = lds + OFF_K + ((t0 + tt) * 64 + hf * 32 + r32) * KS_STRIDE + hi * 16;
#pragma unroll
                    for (int d0 = 0; d0 < 4; ++d0) { const bf16x8 kf = *(const LAS bf16x8*)(kb + d0 * 32); a = __builtin_amdgcn_mfma_f32_32x32x16_bf16(kf, qr[d0], a, 0, 0, 0); }
                    p[tt][hf] = a; }
            float mx = sinkl;
#pragma unroll
            for (int tt = 0; tt < 3; ++tt)
#pragma unroll
                for (int hf = 0; hf < 2; ++hf)
#pragma unroll
                    for (int r = 0; r < 16; ++r) { const int kk = (t0 + tt) * 64 + hf * 32 + crow(r, hi); const int rel = 128 + sb * 32 + r32 - kk;
                        const bool valid = (rel >= 0) && (rel < 128) && (bi > 0 || kk >= 128);
                        const float xv = valid ? p[tt][hf][r] * C2 : -__builtin_inff(); p[tt][hf][r] = xv; mx = fmaxf(mx, xv); }
            const int xl_ = xl_lane(); mx = fmaxf(mx, xl_xor(mx, xl_, 32));
            float ls = 0.f;
#pragma unroll
            for (int tt = 0; tt < 3; ++tt)
#pragma unroll
                for (int hf = 0; hf < 2; ++hf)
#pragma unroll
                    for (int r = 0; r < 16; ++r) { const float e = __builtin_amdgcn_exp2f(p[tt][hf][r] - mx); p[tt][hf][r] = e; ls += e; }
            ls += xl_xor(ls, xl_, 32);
            ls += __builtin_amdgcn_exp2f(sinkl - mx);
            f32x16 o[2] = {};
#pragma unroll
            for (int tt = 0; tt < 3; ++tt)
#pragma unroll
                for (int hf = 0; hf < 2; ++hf)
#pragma unroll
                    for (int s = 0; s < 2; ++s) { const f32x16& P = p[tt][hf]; const int B_ = 8 * s;
                        unsigned a0 = cvtpk(P[B_ + 0], P[B_ + 1]), a1 = cvtpk(P[B_ + 2], P[B_ + 3]), b0 = cvtpk(P[B_ + 4], P[B_ + 5]), b1 = cvtpk(P[B_ + 6], P[B_ + 7]);
                        auto r0 = __builtin_amdgcn_permlane32_swap(a0, b0, false, false); auto r1 = __builtin_amdgcn_permlane32_swap(a1, b1, false, false);
                        v4u w = {r0[0], r1[0], r0[1], r1[1]}; const bf16x8 pa = __builtin_bit_cast(bf16x8, w);
                        const int key0 = (t0 + tt) * 64 + hf * 32 + s * 16 + hi * 8;
#pragma unroll
                        for (int cb = 0; cb < 2; ++cb) { const bf16x8 vf = *(const LAS bf16x8*)(lds + OFF_VT + (cb * 32 + r32) * VT_STRIDE + key0 * 2);
                            o[cb] = __builtin_amdgcn_mfma_f32_32x32x16_bf16(pa, vf, o[cb], 0, 0, 0); } }
            if (hi == 0) Lw[r32] = ls;
            LDS_WAIT(); asm volatile("" ::: "memory");
#pragma unroll
            for (int r = 0; r < 16; ++r) { const float rl = __builtin_amdgcn_rcpf(Lw[crow(r, hi)]);
#pragma unroll
                for (int cb = 0; cb < 2; ++cb) *(LAS unsigned short*)(Ow + crow(r, hi) * O_STRIDE + (cb * 32 + r32) * 2) = (unsigned short)f2bf(o[cb][r] * rl); }
            LDS_WAIT(); asm volatile("" ::: "memory");
#pragma unroll
            for (int i = 0; i < 4; ++i) { const int c = lane + 64 * i, rr = c >> 3, ch = c & 7; const v4u w = *(const LAS v4u*)(Ow + rr * O_STRIDE + ch * 16);
                *(GAS v4u*)(y + (qrow + rr) * DM + hq * 64 + ch * 8) = w; }
            LDS_WAIT(); asm volatile("" ::: "memory");
        }
        __syncthreads();
    }
}
}

#ifndef NO_ATT
#define NO_ATT 0
#endif
#ifndef NO_SWA
#define NO_SWA 0
#endif
#ifndef NO_GATE
#define NO_GATE 0
#endif
#ifndef NO_GEMM
#define NO_GEMM 0
#endif
#ifndef NO_PRO
#define NO_PRO 0
#endif
#ifndef NO_MOBA
#define NO_MOBA 0
#endif
#ifndef DUP_MOBA
#define DUP_MOBA 0
#endif
#ifndef DUP_DIFF
#define DUP_DIFF 0
#endif
#ifndef DUP_FFIN
#define DUP_FFIN 0
#endif
#ifndef DUP_PRO
#define DUP_PRO 0
#endif
#ifndef DUP_GATE
#define DUP_GATE 0
#endif
#ifndef DUP_SWA
#define DUP_SWA 0
#endif
#ifndef DUP_NORM
#define DUP_NORM 0
#endif
#ifndef DUP_KM
#define DUP_KM 0
#endif
#ifndef DUP_COMB
#define DUP_COMB 0
#endif
#ifndef DUP_FFOUT
#define DUP_FFOUT 0
#endif
#ifndef DUP_PROB
#define DUP_PROB 0
#endif
#ifndef DUP_EVIN
#define DUP_EVIN 0
#endif
#ifndef DUP_OUTP
#define DUP_OUTP 0
#endif
#ifndef NO_DIFF
#define NO_DIFF 0
#endif
struct Ctx {
    unsigned char* ws; int G, bx, vcu; int lo, hi; int wv;
};
__device__ __forceinline__ int fresh_tid_w(int wv) { int l; asm volatile("v_mbcnt_lo_u32_b32 %0, -1, 0\n\tv_mbcnt_hi_u32_b32 %0, -1, %0" : "=v"(l)); return wv * 64 + l; }
#define fresh_tid() fresh_tid_w(C.wv)
#if MK_PER_PHASE
#define IN_RANGE(k) (C.lo <= (k) && (k) < C.hi)
#define SEAM() do { ++ph; } while (0)
#else
#define IN_RANGE(k) (true)
#ifndef DUP_BAR
#define DUP_BAR 0
#endif
#define SEAM() do { xcd_barrier(bar, fresh_tid() == 0); if (DUP_BAR) xcd_barrier(bar, fresh_tid() == 0); ++ph; } while (0)
#endif
typedef const __attribute__((address_space(4))) Args* ArgsP;
__device__ __forceinline__ ArgsP launder_args(ArgsP p) { asm volatile("" : "+s"(p)); return p; }
#define A_ (*launder_args(ap))
#define WSP(T, off) ((T*)(A_.ws + (off)))

template <int L>
__device__ __forceinline__ void layer_phases(ArgsP ap, const Ctx& C, const XcdBarrier& bar, int& ph, unsigned char* lds_raw) {
    LAS unsigned char* lds = (LAS unsigned char*)lds_raw;
    constexpr int li = L >> 1; constexpr bool even = (L & 1) == 0;
#define mod (WSP(const float, WS_MOD) + (size_t)L * 2 * NMOD)
    if constexpr (even) {
        for (int rep_ = 0; rep_ < 1 + (L == 0 ? DUP_EVIN : 0); ++rep_)
        if (IN_RANGE(ph)) { if constexpr (!NO_GEMM) {
            pg8::Gemm g{WSP(const bf16, WS_XH), WSP(const bf16, W_EVIN) + (size_t)li * DM * EV_IN, M, EV_IN, DM}; pg8::StaticOrder S; S.init(M, EV_IN, C.G, C.bx);
            pg8::EpiEvenIn E{WSP(bf16, WS_PROJ), WSP(const _Float16, WS_ROPE), WSP(const float, WS_SSP) + (size_t)(2 * L) * 8 * M, WSP(const float, WS_BIAS) + (size_t)((L * 2 + 0) * 2) * pg8::BIAS_BSTRIDE, (LAS float*)(lds + LDSCTL_OFF + 6144)};
            pg8::gemm_phase<pg8::EpiEvenIn, pg8::StaticOrder, true, true>(lds + RING_OFF, g, S, E, C.wv); } }
        SEAM();
        for (int rep_ = 0; rep_ < 1 + (L == 0 ? DUP_KM : 0); ++rep_) if (IN_RANGE(ph)) kmean_phase(WSP(const bf16, WS_PROJ), WSP(float, WS_KM), lds, C.vcu, C.G, fresh_tid());
        SEAM();
        if (IN_RANGE(ph)) { if constexpr (!NO_GATE) gate_phase(WSP(const bf16, WS_PROJ), WSP(const float, WS_KM), WSP(unsigned, WS_CTL) + CW_CNT + li * 1024, WSP(unsigned, WS_LIST), lds, lds_raw, C.vcu, C.G, fresh_tid()); }
        if constexpr (L == 0 && DUP_GATE) { __syncthreads(); gate_phase(WSP(const bf16, WS_PROJ), WSP(const float, WS_KM), WSP(unsigned, WS_CTL) + CW_CNT + 4096, WSP(unsigned, WS_PART), lds, lds_raw, C.vcu, C.G, fresh_tid()); }
        SEAM();
        if (IN_RANGE(ph)) { if constexpr (!NO_ATT) {
            const int xcd = C.vcu >> 5, ci = C.vcu & 31;
            bf16* PROJ = WSP(bf16, WS_PROJ);
            for (int rep_ = 0; rep_ < 1 + (L == 0 ? DUP_MOBA : 0); ++rep_) if constexpr (!NO_MOBA) {
                const int atid = fresh_tid();
                const unsigned* CNT = WSP(const unsigned, WS_CTL) + CW_CNT + li * 1024; const unsigned* LIST = WSP(const unsigned, WS_LIST);
                bf16* PART = WSP(bf16, WS_PART); float* ML = WSP(float, WS_ML);
                LAS unsigned short* pre = (LAS unsigned short*)(lds + LDSCTL_OFF + 3072);
                if (atid < 64) { int loc[16]; int s = 0;
#pragma unroll
                    for (int k = 0; k < 16; ++k) { loc[k] = s; s += (int)((CNT[atid * 16 + k] + 255u) >> 8) + 1; }
                    pre[1040 + atid] = (unsigned short)s; asm volatile("s_waitcnt lgkmcnt(0)" ::: "memory");
                    int base = 0;
                    for (int k = 0; k < atid; ++k) base += pre[1040 + k];
#pragma unroll
                    for (int k = 0; k < 16; ++k) pre[atid * 16 + k] = (unsigned short)(base + loc[k]);
                    if (atid == 63) pre[1024] = (unsigned short)(base + s); }
                __syncthreads();
                const int T = pre[1024];
                unsigned Gq = (unsigned)C.G; asm volatile("" : "+s"(Gq));
                const unsigned tq_ = (unsigned)T / Gq, tr_ = (unsigned)T - tq_ * Gq;
                const int t_begin = (int)((unsigned)C.vcu * tq_ + min((unsigned)C.vcu, tr_)), t_end = (int)((unsigned)(C.vcu + 1) * tq_ + min((unsigned)(C.vcu + 1), tr_));
                auto ref = [&](int t, int& key) { att::SparseRef r;
                    int lo_ = 0, hi_ = 1024;
                    while (hi_ - lo_ > 1) { const int mid = (lo_ + hi_) >> 1; if ((int)pre[mid] <= t) lo_ = mid; else hi_ = mid; }
                    const int e = __builtin_amdgcn_readfirstlane(lo_), idx = t - __builtin_amdgcn_readfirstlane((int)pre[lo_]); const int b = e >> 9, h = (e >> 6) & 7, j = e & 63;
                    const int cnt_e = (int)CNT[e], ntile = (cnt_e + 255) >> 8; const size_t rb = (size_t)b * SEQ;
                    r.Qb = PROJ + rb * EV_IN + h * 128; r.K = PROJ + (rb + j * 256) * EV_IN + 1024 + h * 128; r.V = r.K + 1024; r.dbase = (unsigned)((b * SEQ * 8 + h) * 4);
                    if (idx < ntile) { r.list = LIST + (size_t)e * 16384 + idx * 256; r.q0 = 0; r.nrows = cnt_e - idx * 256; r.causal = 0; }
                    else { r.list = nullptr; r.q0 = j * 256; r.nrows = 256; r.causal = 1; }
                    key = e; return r; };
                if (t_begin < t_end) {
                    int cur_key = -1, key = 0, nkey = 0, bank = 0; att::bf16x8 qr[8];
                    att::SparseRef cur = ref(t_begin, key);
                    att::sparse2_prime(cur, (char*)lds_raw, atid, qr, EV_IN);
                    for (int t = t_begin; t < t_end; ++t) {
                        const bool has_next = t + 1 < t_end; const att::SparseRef nxt = has_next ? ref(t + 1, nkey) : cur;
                        if (key != cur_key) { __syncthreads(); att::sparse2_stage<EV_IN>(cur.K, cur.V, (char*)lds_raw, atid); __syncthreads(); cur_key = key; }
                        att::sparse2_wave<EV_IN>(cur, nxt, has_next, bank, PART, ML, (char*)lds_raw, atid, qr);
                        cur = nxt; key = nkey; bank ^= 1;
                    }
                }
            }
            for (int rep_ = 0; rep_ < 1 + (L == 0 ? DUP_DIFF : 0); ++rep_) if constexpr (!NO_DIFF) {
                const int atid = fresh_tid();
                bf16* OT = WSP(bf16, WS_OT);
                __syncthreads();
                for (int n = 0; n < 4; ++n) { const int vh = 2 * xcd + (n >> 1), b = vh >> 3, hb = (vh >> 1) & 3, mp = vh & 1, qb = (n & 1) ? 63 - ci : ci; att::Block2Ref r;
                    const size_t rq = (size_t)b * SEQ + qb * 256;
                    r.Q = PROJ + rq * EV_IN + 3072 + (hb * 2 + mp) * 128; r.K = PROJ + (size_t)b * SEQ * EV_IN + 4096 + (hb * 2 + mp) * 128; r.V = PROJ + (size_t)b * SEQ * EV_IN + 5120 + hb * 256;
                    r.O = OT + rq * DM + hb * 512 + mp * 256; r.P0 = qb * 256;
                    att::causal_block2<EV_IN, DM>(r, (char*)lds_raw, atid); }
            }
        } }
        SEAM();
        for (int rep_ = 0; rep_ < 1 + (L == 0 ? DUP_COMB : 0); ++rep_) if (IN_RANGE(ph)) { const int tid = fresh_tid(), lane = tid & 63, wave = __builtin_amdgcn_readfirstlane(tid >> 6);
            diff_combine_phase(WSP(const bf16, WS_OT), WSP(bf16, WS_Y), A_.diff_lambda + li * 512, A_.diff_subln + li * 256, A_.lam_init[L], C.vcu * NWAVES + wave, C.G * NWAVES, lane);
            moba_combine_phase(WSP(const bf16, WS_PART), WSP(const float, WS_ML), WSP(bf16, WS_Y), C.vcu * NWAVES + wave, C.G * NWAVES, lane); }
        SEAM();
        if (IN_RANGE(ph)) { if constexpr (!NO_GEMM) {
            pg8::Gemm g{WSP(const bf16, WS_Y), WSP(const bf16, W_EVOUT) + (size_t)li * DM * DM, M, DM, DM}; pg8::StaticOrder S; S.init(M, DM, C.G, C.bx);
            using Epi = pg8::EpiResidH<false, true>;
            Epi E{(const void*)WSP(const bf16, WS_XH), WSP(bf16, WS_XH), WSP(bf16, WS_OT), mod + 2 * DM, nullptr, mod + 1 * DM, mod + 4 * DM, WSP(float, WS_SSP) + (size_t)(2 * L + 1) * 8 * M, (LAS float*)(lds + LDSCTL_OFF + 2048)};
            pg8::gemm_phase<Epi, pg8::StaticOrder, true, true>(lds + RING_OFF, g, S, E, C.wv); } }
        SEAM();
    } else {
        if (IN_RANGE(ph)) { if constexpr (!NO_GEMM) {
            pg8::Gemm g{WSP(const bf16, WS_XH), WSP(const bf16, W_ODIN) + (size_t)li * DM * OD_IN, M, OD_IN, DM}; pg8::OddInOrder S{C.bx};
            pg8::EpiOddIn E{WSP(bf16, WS_PROJ), WSP(const _Float16, WS_ROPE) + SEQ * 128, WSP(const float, WS_SSP) + (size_t)(2 * L) * 8 * M, WSP(const float, WS_BIAS) + (size_t)((L * 2 + 0) * 2) * pg8::BIAS_BSTRIDE, (LAS float*)(lds + LDSCTL_OFF + 6144)};
            pg8::gemm_phase<pg8::EpiOddIn, pg8::OddInOrder, true, true>(lds + RING_OFF, g, S, E, C.wv); } }
        SEAM();
        for (int rep_ = 0; rep_ < 1 + (L == 1 ? DUP_SWA : 0); ++rep_) if (IN_RANGE(ph)) { if constexpr (!NO_SWA) swa::phase(WSP(const bf16, WS_PROJ), WSP(bf16, WS_Y), A_.swa_sinks + li * 32, lds, C.vcu, C.G, fresh_tid()); }
        SEAM();
        if (IN_RANGE(ph)) { if constexpr (!NO_GEMM) {
            pg8::Gemm g{WSP(const bf16, WS_Y), WSP(const bf16, W_ODOUT) + (size_t)li * DM * DM, M, DM, DM}; pg8::StaticOrder S; S.init(M, DM, C.G, C.bx);
            using Epi = pg8::EpiResidH<false, true>;
            Epi E{(const void*)WSP(const bf16, WS_XH), WSP(bf16, WS_XH), WSP(bf16, WS_OT), mod + 2 * DM, A_.swa_b_out + li * DM, mod + 1 * DM, mod + 4 * DM, WSP(float, WS_SSP) + (size_t)(2 * L + 1) * 8 * M, (LAS float*)(lds + LDSCTL_OFF + 2048)};
            pg8::gemm_phase<Epi, pg8::StaticOrder, true, true>(lds + RING_OFF, g, S, E, C.wv); } }
        SEAM();
    }
    for (int rep_ = 0; rep_ < 1 + (L == 0 ? DUP_FFIN : 0); ++rep_)
    if (IN_RANGE(ph)) { if constexpr (!NO_GEMM) {
        pg8::Gemm g{WSP(const bf16, WS_XH), WSP(const bf16, W_FFIN) + (size_t)L * DM * FF2, M, FF2, DM}; pg8::FfnInOrder S{C.bx};
        pg8::EpiFfnIn E{WSP(bf16, WS_PROJ), WSP(const float, WS_SSP) + (size_t)(2 * L + 1) * 8 * M, WSP(const float, WS_BIAS) + (size_t)((L * 2 + 1) * 2) * pg8::BIAS_BSTRIDE, (LAS float*)(lds + LDSCTL_OFF + 6144)};
        pg8::gemm_phase<pg8::EpiFfnIn, pg8::FfnInOrder, true, true>(lds + RING_OFF, g, S, E, C.wv); } }
    SEAM();
    if (IN_RANGE(ph)) { if constexpr (!NO_GEMM) {
        pg8::Gemm g{WSP(const bf16, WS_PROJ), WSP(const bf16, W_FFOUT) + (size_t)L * FFH * DM, M, DM, FFH}; pg8::StaticOrder S; S.init(M, DM, C.G, C.bx);
        using Epi = pg8::EpiResidH<false, (L < DEPTH - 1)>;
        Epi E{(const void*)WSP(const bf16, WS_XH), WSP(bf16, WS_XH), WSP(bf16, WS_OT)  , mod + 5 * DM, nullptr, mod + 4 * DM, (L < DEPTH - 1) ? mod + 2 * NMOD + 1 * DM : mod + 4 * DM, WSP(float, WS_SSP) + (size_t)(2 * L + 2) * 8 * M, (LAS float*)(lds + LDSCTL_OFF + 2048)};
        pg8::gemm_phase<Epi, pg8::StaticOrder, true, true>(lds + RING_OFF, g, S, E, C.wv); } }
    SEAM();
}

#undef mod
__device__ __forceinline__ void prologue_phase(ArgsP ap, const Ctx& C, unsigned char* lds_raw) {
    const __attribute__((address_space(4))) Args& args = *launder_args(ap);
    LAS unsigned char* lds = (LAS unsigned char*)lds_raw;
    const int tid = fresh_tid(), lane = tid & 63, wave = __builtin_amdgcn_readfirstlane(tid >> 6);
    const int G = C.G, vcu = C.vcu, gw = vcu * NWAVES + wave, NGW = G * NWAVES;
    unsigned char* ws = args.ws;
    float* MOD = WSP(float, WS_MOD);
    _Float16* T128 = WSP(_Float16, WS_ROPE); _Float16* T64 = T128 + SEQ * 128;
    LAS float* cond = (LAS float*)(lds + 73728);
    LAS float* red = (LAS float*)(lds + 90112);
    for (int e = tid; e < 2 * DM; e += NTHR) { const float cv = args.c[e]; cond[e] = cv / (1.0f + __expf(-cv)); }
    __syncthreads();
    for (int it = vcu; it < DEPTH * (NMOD / 64); it += G) {
        const int l = it / (NMOD / 64), ch = it % (NMOD / 64);
        const float s = gemv2_chunk(args.ada_w + (size_t)l * DM * NMOD, NMOD, ch, cond, red, tid);
        if (tid < 128) { const int b = tid >> 6, col = tid & 63; MOD[((size_t)l * 2 + b) * NMOD + ch * 64 + col] = s + args.ada_b[(size_t)l * NMOD + ch * 64 + col]; }
    }
    for (int e = gw * 64 + lane; e < SEQ * 64; e += NGW * 64) { const int pos = e >> 6, i = e & 63; const float ang = (float)pos * args.invf128[i]; double s, c; dsincos((double)ang, s, c); _Float16* t = T128 + ((size_t)((pos >> 4) * 8 + (i >> 3)) * 32 + (pos & 15)) * 8 + (i & 7); t[0] = (_Float16)(float)c; t[128] = (_Float16)(float)s; }
    for (int e = gw * 64 + lane; e < SEQ * 32; e += NGW * 64) { const int pos = e >> 5, i = e & 31; const float ang = (float)pos * args.invf64[i]; double s, c; dsincos((double)ang, s, c); _Float16* t = T64 + ((size_t)((pos >> 4) * 4 + (i >> 3)) * 32 + (pos & 15)) * 8 + (i & 7); t[0] = (_Float16)(float)c; t[128] = (_Float16)(float)s; }
}


__device__ __forceinline__ void prologue_b_phase(ArgsP ap, const Ctx& C, unsigned char* lds_raw) {
    const __attribute__((address_space(4))) Args& args = *launder_args(ap);
    LAS unsigned char* lds = (LAS unsigned char*)lds_raw;
    const int tid = fresh_tid(), lane = tid & 63, wave = __builtin_amdgcn_readfirstlane(tid >> 6);
    const int G = C.G, vcu = C.vcu, gw = vcu * NWAVES + wave, NGW = G * NWAVES;
    unsigned char* ws = args.ws;
    const float* MOD = (const float*)(ws + WS_MOD); float* BIAS = (float*)(ws + WS_BIAS);
    LAS float* scr = (LAS float*)(lds + wave * 8704);
    for (int s = gw; s < 1952; s += NGW) {
        int r = s, Lk, kind; const float* W; int N; bf16* WT;
        if (r < 384) { const int i = r / 192; r -= i * 192; Lk = 2 * i; kind = 0; N = EV_IN; W = args.ab_w_in + (size_t)i * DM * N; WT = (bf16*)(ws + W_EVIN) + (size_t)i * DM * N; }
        else if ((r -= 384) < 160) { const int i = r / 80; r -= i * 80; Lk = 2 * i + 1; kind = 0; N = OD_IN; W = args.swa_w_in + (size_t)i * DM * N; WT = (bf16*)(ws + W_ODIN) + (size_t)i * DM * N; }
        else { r -= 160; const int l = r / 352; r -= l * 352; Lk = l; kind = 1; N = FF2; W = args.ffn_w_in + (size_t)l * DM * N; WT = (bf16*)(ws + W_FFIN) + (size_t)l * DM * N; }
        const float* sh0 = MOD + (size_t)Lk * 2 * NMOD + (kind ? 3 * DM : 0);
        const int nblk = N / 32; f32x4 pb[2] = {{0.f, 0.f, 0.f, 0.f}, {0.f, 0.f, 0.f, 0.f}};
        if (kind == 1) p0_run<3, pg8::XA_F16, true>(W, DM, N, WT, scr, lane, r, nblk, DM / 64, sh0, pb);
        else if (Lk & 1) p0_run<2, pg8::XA_F16, true>(W, DM, N, WT, scr, lane, r, nblk, DM / 64, sh0, pb);
        else p0_run<1, pg8::XA_F16, true>(W, DM, N, WT, scr, lane, r, nblk, DM / 64, sh0, pb);
        { const int l_ = xl_lane();
#pragma unroll
          for (int b = 0; b < 2; ++b)
#pragma unroll
            for (int q = 0; q < 4; ++q) { float v = pb[b][q]; v += xl_xor(v, l_, 8); v += xl_xor(v, l_, 16); v += xl_xor(v, l_, 32); pb[b][q] = v; } }
        if (lane < 8) {
#pragma unroll
            for (int q = 0; q < 4; ++q) { const int n = r * 32 + 4 * lane + q; int dst; float add = 0.f;
                if (kind == 1) dst = pg8::perm_ffn_in(n); else if (Lk & 1) { dst = pg8::perm_odd_in(n); add = args.swa_b_in[(Lk >> 1) * OD_IN + n]; } else dst = pg8::perm_even_in(n);
                BIAS[(size_t)((Lk * 2 + kind) * 2 + 0) * pg8::BIAS_BSTRIDE + dst] = pb[0][q] + add; BIAS[(size_t)((Lk * 2 + kind) * 2 + 1) * pg8::BIAS_BSTRIDE + dst] = pb[1][q] + add; } }
    }
    { int base = 1952 * 32;
      for (int i = 0; i < 2; ++i) {
        { const int K = DM, N = DM, NI = (K / 64) * (N / 32); const float* W = args.ab_w_out + (size_t)i * K * N; bf16* WT = (bf16*)(ws + W_EVOUT) + (size_t)i * K * N;
          { const int st_ = ((gw - base) % NGW + NGW) % NGW; p0_run<0, false, false>(W, K, N, WT, scr, lane, st_, NGW, st_ < NI ? (NI - st_ + NGW - 1) / NGW : 0); } base += NI; }
        { const int K = DM, N = DM, NI = (K / 64) * (N / 32); const float* W = args.swa_w_out + (size_t)i * K * N; bf16* WT = (bf16*)(ws + W_ODOUT) + (size_t)i * K * N;
          { const int st_ = ((gw - base) % NGW + NGW) % NGW; p0_run<0, false, false>(W, K, N, WT, scr, lane, st_, NGW, st_ < NI ? (NI - st_ + NGW - 1) / NGW : 0); } base += NI; } }
      for (int l = 0; l < DEPTH; ++l) { const int K = FFH, N = DM, NI = (K / 64) * (N / 32); const float* W = args.ffn_w_out + (size_t)l * K * N; bf16* WT = (bf16*)(ws + W_FFOUT) + (size_t)l * K * N;
          { const int st_ = ((gw - base) % NGW + NGW) % NGW; p0_run<0, false, false>(W, K, N, WT, scr, lane, st_, NGW, st_ < NI ? (NI - st_ + NGW - 1) / NGW : 0); } base += NI; } }
    first_norm_phase(args.x, MOD + 1 * DM, (bf16*)(ws + WS_XH), (float*)(ws + WS_SSP), gw, NGW, lane);
}

__global__ void __launch_bounds__(NTHR, 2) trunk_fwd(Args args) {
    extern __shared__ __attribute__((aligned(16))) unsigned char lds_raw[];
    LAS unsigned char* lds = (LAS unsigned char*)lds_raw;
    volatile LAS unsigned* MISC = (volatile LAS unsigned*)(lds + MISC_OFF);
    ArgsP ap = (ArgsP)__builtin_amdgcn_kernarg_segment_ptr();
    Ctx C; C.ws = nullptr; C.G = gridDim.x; C.bx = blockIdx.x; C.vcu = (C.G % 8 == 0) ? (C.bx % 8) * (C.G / 8) + C.bx / 8 : C.bx; C.lo = args.ph_lo; C.hi = args.ph_hi; C.wv = __builtin_amdgcn_readfirstlane(threadIdx.x >> 6);
    { const int tid = threadIdx.x; for (int u = tid; u < (LDS_BYTES - LDSCTL_OFF) / 4; u += NTHR) ((LAS unsigned*)(lds + LDSCTL_OFF))[u] = 0u; }
    __syncthreads();
#if MK_PER_PHASE
    XcdBarrier bar; bar.bar = nullptr; bar.x = 0; bar.st = nullptr; bar.G = 0;
#else
    XcdBarrier bar = xcd_barrier_post((unsigned*)(args.ws + WS_CTL) + CW_BAR, MISC + 8, threadIdx.x == 0);
#endif
    int ph = 0;
    for (int rep_ = 0; rep_ < 1 + DUP_PRO; ++rep_) { if (IN_RANGE(ph)) { if constexpr (!NO_PRO) prologue_phase(ap, C, lds_raw); } __syncthreads(); }
    SEAM();
    for (int rep_ = 0; rep_ < 1 + DUP_PROB; ++rep_) { if (IN_RANGE(ph)) { if constexpr (!NO_PRO) prologue_b_phase(ap, C, lds_raw); } __syncthreads(); }
    SEAM();
    layer_phases<0>(ap, C, bar, ph, lds_raw);
#if NLAYERS_RUN > 1
    layer_phases<1>(ap, C, bar, ph, lds_raw);
    layer_phases<2>(ap, C, bar, ph, lds_raw);
    layer_phases<3>(ap, C, bar, ph, lds_raw);
#endif
    if (IN_RANGE(ph)) { const int tid = fresh_tid(), lane = tid & 63, wave = __builtin_amdgcn_readfirstlane(tid >> 6); final_norm_phase(WSP(const bf16, WS_OT), WSP(const float, WS_SSP) + (size_t)8 * 8 * M, A_.final_norm, A_.out, C.vcu * NWAVES + wave, C.G * NWAVES, lane); }
}
#undef IN_RANGE
#undef SEAM
#undef WSP
#undef A_
constexpr int N_PHASES = 2 + 2 * 8 + 2 * 5 + 1;

extern "C" void kernel_launch(void* const* d_in, const int* in_sizes, int n_in, void* d_out, int out_size, void* d_ws, size_t ws_size, hipStream_t stream) {
    static int grid = 0;
    if (grid == 0) {
        if (n_in != 16 || in_sizes[0] != M * DM || out_size != M * DM || ws_size < WS_END) { fprintf(stderr, "kernel_launch: unexpected shapes (n_in %d, in0 %d, out %d, ws %zu < %zu); nothing launched\n", n_in, n_in > 0 ? in_sizes[0] : -1, out_size, ws_size, (size_t)WS_END); grid = -1; return; }
        int dev = 0, cus = 0, per_cu = 0;
        if (hipGetDevice(&dev) != hipSuccess || hipDeviceGetAttribute(&cus, hipDeviceAttributeMultiprocessorCount, dev) != hipSuccess) { fprintf(stderr, "kernel_launch: device query failed\n"); grid = -1; return; }
        if (hipFuncSetAttribute((const void*)trunk_fwd, hipFuncAttributeMaxDynamicSharedMemorySize, LDS_BYTES) != hipSuccess) { fprintf(stderr, "kernel_launch: hipFuncSetAttribute failed\n"); grid = -1; return; }
        if (hipOccupancyMaxActiveBlocksPerMultiprocessor(&per_cu, (const void*)trunk_fwd, NTHR, LDS_BYTES) != hipSuccess || per_cu < 1) fprintf(stderr, "kernel_launch: note: occupancy query reports %d workgroups per CU\n", per_cu);
        (void)hipGetLastError();
        grid = cus;
        if (grid != 256) fprintf(stderr, "kernel_launch: built for 256 CUs, device has %d\n", grid);
    }
    if (grid < 0) return;
    if (hipMemsetAsync((char*)d_ws + WS_CTL, 0, CTL_ZERO_BYTES, stream) != hipSuccess) { fprintf(stderr, "kernel_launch: memset failed\n"); return; }
    Args a{};
    a.x = (const float*)d_in[0]; a.c = (const float*)d_in[1]; a.ada_w = (const float*)d_in[2]; a.ada_b = (const float*)d_in[3]; a.ab_w_in = (const float*)d_in[4]; a.ab_w_out = (const float*)d_in[5];
    a.diff_lambda = (const float*)d_in[6]; a.diff_subln = (const float*)d_in[7]; a.swa_w_in = (const float*)d_in[8]; a.swa_b_in = (const float*)d_in[9]; a.swa_w_out = (const float*)d_in[10];
    a.swa_b_out = (const float*)d_in[11]; a.swa_sinks = (const float*)d_in[12]; a.ffn_w_in = (const float*)d_in[13]; a.ffn_w_out = (const float*)d_in[14]; a.final_norm = (const float*)d_in[15];
    a.out = (float*)d_out; a.ws = (unsigned char*)d_ws;
    for (int i = 0; i < 64; ++i) a.invf128[i] = powf(10000.0f, -((float)(2 * i) / 128.0f));
    for (int i = 0; i < 32; ++i) a.invf64[i] = powf(10000.0f, -((float)(2 * i) / 64.0f));
    for (int l = 0; l < 4; ++l) a.lam_init[l] = (float)(0.8 - 0.6 * exp(-0.3 * (double)l));
#if MK_PER_PHASE
    for (int p = 0; p < N_PHASES; ++p) { a.ph_lo = p; a.ph_hi = p + 1; hipLaunchKernelGGL(trunk_fwd, dim3(grid), dim3(NTHR), LDS_BYTES, stream, a); }
#else
    a.ph_lo = 0; a.ph_hi = N_PHASES;
    hipLaunchKernelGGL(trunk_fwd, dim3(grid), dim3(NTHR), LDS_BYTES, stream, a);
#endif
    const hipError_t le = hipPeekAtLastError();
    if (le != hipSuccess) fprintf(stderr, "kernel_launch: launch failed: %s\n", hipGetErrorName(le));
}
```

```cpp
#include <hip/hip_runtime.h>
#include <cstdio>
#include <cstdint>
#include <cmath>

__device__ __forceinline__ float xl_xor(float v, int lane, int mask) { return __builtin_bit_cast(float, __builtin_amdgcn_ds_bpermute((lane ^ mask) << 2, __builtin_bit_cast(int, v))); }
__device__ __forceinline__ int xl_lane() { int l; asm volatile("v_mbcnt_lo_u32_b32 %0, -1, 0\n\tv_mbcnt_hi_u32_b32 %0, -1, %0" : "=v"(l)); return l; }
namespace pg8 {
#define PG8_LAS __attribute__((address_space(3)))
typedef unsigned short bf16_t;
typedef short bf16x8 __attribute__((ext_vector_type(8)));
typedef float f32x4 __attribute__((ext_vector_type(4)));
typedef unsigned u32x4 __attribute__((ext_vector_type(4)));
constexpr int BM = 256, BK = 64, HALF = 128, HTB = HALF * BK * 2  , STAGE_BYTES = 8 * HTB, NXCD = 8, WGM = 4;

__host__ __device__ __forceinline__ int lds_byte(int r, int c) { const int st = (r >> 4) * 2 + (c >> 5), rr = r & 15, cc = c & 31, ob = rr * 64 + cc * 2; return st * 1024 + (ob ^ (((ob >> 9) & 1) << 5)); }
__host__ __device__ __forceinline__ void stage_rc(int b, int& R, int& C) { const int st = b / 1024, sb = b % 1024, swz = sb ^ (((sb >> 9) & 1) << 5); R = (st >> 1) * 16 + swz / 64; C = (st & 1) * 32 + (swz % 64) / 2; }
__host__ __device__ __forceinline__ int perm32(int rho) { const int n = rho >> 4, i = rho & 15; return 8 * (i >> 2) + 4 * n + (i & 3); }

struct Unit { int pm, pn; };
struct Gemm { const bf16_t* A; const bf16_t* Bt; int M, N, K; };

struct StaticOrder {
    int nM, nN, nwg, G, c;
    __host__ __device__ void init(int M, int N, int G_, int c_) { nM = M / BM; nN = N / BM; nwg = nM * nN; G = G_; c = c_; }
    __host__ __device__ bool next(int i, Unit& u) const {
        const long L = (long)i * G + c; if (L >= nwg) return false;
        int wgid = (int)L; { const int q = nwg / NXCD, r = nwg % NXCD, xcd = wgid % NXCD, off = wgid / NXCD; wgid = (xcd < r ? xcd * (q + 1) : r * (q + 1) + (xcd - r) * q) + off; }
        const int nig = WGM * nN, gid = wgid / nig, fm = gid * WGM, gsz = (nM - fm) < WGM ? (nM - fm) : WGM;
        u.pm = fm + ((wgid % nig) % gsz); u.pn = (wgid % nig) / gsz; return true;
    }
    __device__ __forceinline__ void a_ready(const Unit&) const {}
    __device__ __forceinline__ void done(const Unit&) const {}
};

__device__ __forceinline__ unsigned cvt_pk_bf16(float lo, float hi) { unsigned r; asm volatile("v_cvt_pk_bf16_f32 %0, %1, %2" : "=v"(r) : "v"(lo), "v"(hi)); return r; }
typedef float f32x2 __attribute__((ext_vector_type(2)));
typedef unsigned u32x2 __attribute__((ext_vector_type(2)));
constexpr int SEQ_LEN = 16384;
typedef _Float16 f16x8 __attribute__((ext_vector_type(8)));
typedef _Float16 f16x4 __attribute__((ext_vector_type(4)));
template <bool F16> __device__ __forceinline__ f32x4 mma16(bf16x8 a, bf16x8 b, f32x4 c) {
    if constexpr (F16) return __builtin_amdgcn_mfma_f32_16x16x32_f16(__builtin_bit_cast(f16x8, a), __builtin_bit_cast(f16x8, b), c, 0, 0, 0);
    else return __builtin_amdgcn_mfma_f32_16x16x32_bf16(a, b, c, 0, 0, 0);
}
__device__ __forceinline__ u32x2 pack4h(f32x4 v) { f16x4 h = {(_Float16)v[0], (_Float16)v[1], (_Float16)v[2], (_Float16)v[3]}; return __builtin_bit_cast(u32x2, h); }
#ifndef MK_XA_F16
#define MK_XA_F16 0
#endif
constexpr bool XA_F16 = MK_XA_F16 != 0;
constexpr int BIAS_BSTRIDE = 11264;
constexpr float NORM_EPS = 1e-6f, INV_DM = 1.0f / 2048.0f;
constexpr int SS_PSTRIDE = 2 * 16384;
__device__ __forceinline__ void load_rstd(float (&rs)[2][4], const float* ss, int row0) {
#pragma unroll
    for (int ai = 0; ai < 2; ++ai)
#pragma unroll
        for (int m = 0; m < 4; ++m) rs[ai][m] = __builtin_amdgcn_rsqf(ss[row0 + ai * HALF + m * 16] * INV_DM + NORM_EPS);
}

__host__ __device__ __forceinline__ int rope128_slot(int d) { return d; }
__host__ __device__ __forceinline__ int rope64_slot(int d) { return 8 * ((d & 31) >> 2) + 4 * (d >> 5) + (d & 3); }
__host__ __device__ __forceinline__ int perm_even_in(int c) { const int region = c >> 10; if (region == 2 || region == 5) return c; const int hh = (c >> 7) & 1, d = c & 127;
    return (c & ~255) + 128 * (d >> 6) + 32 * (2 * hh + ((d >> 5) & 1)) + (d & 31); }
__host__ __device__ __forceinline__ int perm_odd_in(int c) { if (c >= 2304) return c; const int hh = (c >> 6) & 3, d = c & 63; return (c & ~255) + 128 * (d >> 5) + 32 * hh + (d & 31); }
__host__ __device__ __forceinline__ int perm_ffn_in(int c) { const int up = c >= 5632 ? 1 : 0; const int j = c - up * 5632; return 256 * (j >> 7) + 128 * up + (j & 127); }

__device__ __forceinline__ u32x2 pack4(f32x4 v) { u32x2 w; w.x = cvt_pk_bf16(v[0], v[1]); w.y = cvt_pk_bf16(v[2], v[3]); return w; }


template <int TROW, int OSTR, int W2B>
__device__ __forceinline__ void rope_rows(const f32x4 (&acc)[2][2][4][2], const float (&rs)[2][4], const PG8_LAS float* pfb, const char* tu, unsigned vt, char* ou, unsigned vs) {
    u32x4 tc0[2], ts0[2], tc1[2], ts1[2];
#define RP_LOAD(TC, TS, it) do { _Pragma("unroll") for (int mm = 0; mm < 2; ++mm) { const char* p_ = tu + (size_t)(((it) >> 1) * HALF + (((it) & 1) * 2 + mm) * 16) * TROW; \
            TC[mm] = *(const u32x4*)(p_ + vt); TS[mm] = *(const u32x4*)(p_ + 256 + vt); } asm volatile("" ::: "memory"); } while (0)
#define RP_PIN(TC, TS) asm volatile("" : "+v"(TC[0]), "+v"(TC[1]), "+v"(TS[0]), "+v"(TS[1]) :: "memory")
#define RP_BODY(TC, TS, it) do { const int ai = (it) >> 1; _Pragma("unroll") for (int mm = 0; mm < 2; ++mm) { const int m = ((it) & 1) * 2 + mm; \
            const f16x8 ch = __builtin_bit_cast(f16x8, TC[mm]), sh = __builtin_bit_cast(f16x8, TS[mm]); u32x4 w1, w2; \
            _Pragma("unroll") for (int n = 0; n < 2; ++n) { \
                const f32x4 cv = {(float)ch[4 * n], (float)ch[4 * n + 1], (float)ch[4 * n + 2], (float)ch[4 * n + 3]}, sv = {(float)sh[4 * n], (float)sh[4 * n + 1], (float)sh[4 * n + 2], (float)sh[4 * n + 3]}; \
                const f32x4 x1 = acc[ai][0][m][n] * rs[ai][m] + *(const PG8_LAS f32x4*)(pfb + 4 * n), x2 = acc[ai][1][m][n] * rs[ai][m] + *(const PG8_LAS f32x4*)(pfb + HALF + 4 * n); \
                const u32x2 a = pack4(x1 * cv - x2 * sv), b = pack4(x2 * cv + x1 * sv); \
                if (n == 0) { w1.x = a.x; w1.y = a.y; w2.x = b.x; w2.y = b.y; } else { w1.z = a.x; w1.w = a.y; w2.z = b.x; w2.w = b.y; } } \
            char* p = ou + (size_t)(ai * HALF + m * 16) * OSTR * 2; *(u32x4*)(p + vs) = w1; *(u32x4*)(p + W2B + vs) = w2; } \
        asm volatile("" ::: "memory"); } while (0)
    RP_LOAD(tc0, ts0, 0);
    RP_LOAD(tc1, ts1, 1); asm volatile("s_waitcnt vmcnt(4)" ::: "memory"); RP_PIN(tc0, ts0); RP_BODY(tc0, ts0, 0);
    RP_LOAD(tc0, ts0, 2); asm volatile("s_waitcnt vmcnt(8)" ::: "memory"); RP_PIN(tc1, ts1); RP_BODY(tc1, ts1, 1);
    RP_LOAD(tc1, ts1, 3); asm volatile("s_waitcnt vmcnt(8)" ::: "memory"); RP_PIN(tc0, ts0); RP_BODY(tc0, ts0, 2);
    asm volatile("s_waitcnt vmcnt(4)" ::: "memory"); RP_PIN(tc1, ts1); RP_BODY(tc1, ts1, 3);
#undef RP_LOAD
#undef RP_PIN
#undef RP_BODY
}
struct EpiEvenIn {
    static constexpr bool PERM = true, AFTER_DRAIN = false, F16 = XA_F16;
    bf16_t* O; const _Float16* tab; const float* ss; const float* bias0; PG8_LAS float* pf;
    __device__ __forceinline__ float prefetch(const Unit& u, int tid) const { if (tid < 256) { const float* p = ss + u.pm * BM + tid; float a = p[0];
#pragma unroll
            for (int j = 1; j < 8; ++j) a += p[(size_t)j * SS_PSTRIDE]; return a; }
        return bias0[(u.pm >= (SEQ_LEN / BM) ? BIAS_BSTRIDE : 0) + u.pn * BM + (tid - 256)]; }
    __device__ __forceinline__ void operator()(const f32x4 (&acc)[2][2][4][2], const Unit& u, int wr, int wc, int fr_, int fq_, float epre) const {
        int lane_; asm volatile("v_mbcnt_lo_u32_b32 %0, -1, 0\n\tv_mbcnt_hi_u32_b32 %0, -1, %0" : "=v"(lane_)); const int fr = lane_ & 15, fq = lane_ >> 4; (void)fr_; (void)fq_;
        const int row0 = u.pm * BM + wr * 64 + fr; const int region = u.pn >> 2;
        pf[(wr * 4 + wc) * 64 + lane_] = epre;
        asm volatile("s_waitcnt lgkmcnt(0)" ::: "memory"); __builtin_amdgcn_s_barrier(); asm volatile("" ::: "memory");
        float rs[2][4];
#pragma unroll
        for (int ai = 0; ai < 2; ++ai)
#pragma unroll
            for (int m = 0; m < 4; ++m) rs[ai][m] = __builtin_amdgcn_rsqf(pf[ai * HALF + wr * 64 + m * 16 + fr] * INV_DM + NORM_EPS);
        f32x4 bb[2][2];
#pragma unroll
        for (int bj = 0; bj < 2; ++bj)
#pragma unroll
            for (int n = 0; n < 2; ++n) bb[bj][n] = *(const PG8_LAS f32x4*)(pf + 256 + bj * HALF + wc * 32 + 8 * fq + 4 * n);
        if (region != 2 && region != 5) {
            const char* tu = (const char*)tab + (size_t)((u.pm & (SEQ_LEN / BM - 1)) * BM + wr * 64) * 256 + (wc & 1) * 2048;
            char* ou = (char*)O + ((size_t)(u.pm * BM + wr * 64) * 6144 + u.pn * BM + (wc >> 1) * HALF + 32 * (wc & 1)) * 2;
            rope_rows<256, 6144, 128>(acc, rs, pf + 256 + wc * 32 + 8 * fq, tu, (unsigned)(fq * 512 + fr * 16), ou, (unsigned)(fr * 6144 + 8 * fq) * 2u);
        } else {
            const int col0 = u.pn * BM + wc * 32 + 8 * fq;
#pragma unroll
            for (int ai = 0; ai < 2; ++ai)
#pragma unroll
                for (int m = 0; m < 4; ++m) { bf16_t* rowp = O + (size_t)(row0 + ai * HALF + m * 16) * 6144 + col0;
#pragma unroll
                    for (int bj = 0; bj < 2; ++bj) { const f32x4 v0 = acc[ai][bj][m][0] * rs[ai][m] + bb[bj][0], v1 = acc[ai][bj][m][1] * rs[ai][m] + bb[bj][1];
                        u32x4 w; w.x = cvt_pk_bf16(v0[0], v0[1]); w.y = cvt_pk_bf16(v0[2], v0[3]); w.z = cvt_pk_bf16(v1[0], v1[1]); w.w = cvt_pk_bf16(v1[2], v1[3]);
                        *(u32x4*)(rowp + bj * HALF) = w; } }
        }
    }
};
struct EpiOddIn {
    static constexpr bool PERM = true, AFTER_DRAIN = false, F16 = XA_F16;
    bf16_t* O; const _Float16* tab; const float* ss; const float* bias0; PG8_LAS float* pf;
    __device__ __forceinline__ float prefetch(const Unit& u, int tid) const { if (tid < 256) { const float* p = ss + u.pm * BM + tid; float a = p[0];
#pragma unroll
            for (int j = 1; j < 8; ++j) a += p[(size_t)j * SS_PSTRIDE]; return a; }
        return bias0[(u.pm >= (SEQ_LEN / BM) ? BIAS_BSTRIDE : 0) + u.pn * BM + (tid - 256)]; }
    __device__ __forceinline__ void operator()(const f32x4 (&acc)[2][2][4][2], const Unit& u, int wr, int wc, int fr_, int fq_, float epre) const {
        int lane_; asm volatile("v_mbcnt_lo_u32_b32 %0, -1, 0\n\tv_mbcnt_hi_u32_b32 %0, -1, %0" : "=v"(lane_)); const int fr = lane_ & 15, fq = lane_ >> 4; (void)fr_; (void)fq_;
        const int row0 = u.pm * BM + wr * 64 + fr;
        pf[(wr * 4 + wc) * 64 + lane_] = epre;
        asm volatile("s_waitcnt lgkmcnt(0)" ::: "memory"); __builtin_amdgcn_s_barrier(); asm volatile("" ::: "memory");
        float rs[2][4];
#pragma unroll
        for (int ai = 0; ai < 2; ++ai)
#pragma unroll
            for (int m = 0; m < 4; ++m) rs[ai][m] = __builtin_amdgcn_rsqf(pf[ai * HALF + wr * 64 + m * 16 + fr] * INV_DM + NORM_EPS);
        f32x4 bb[2][2];
#pragma unroll
        for (int bj = 0; bj < 2; ++bj)
#pragma unroll
            for (int n = 0; n < 2; ++n) bb[bj][n] = *(const PG8_LAS f32x4*)(pf + 256 + bj * HALF + wc * 32 + 8 * fq + 4 * n);
        if (u.pn < 9) {
            const char* tu = (const char*)tab + (size_t)((u.pm & (SEQ_LEN / BM - 1)) * BM + wr * 64) * 128;
            char* ou = (char*)O + ((size_t)(u.pm * BM + wr * 64) * 2560 + u.pn * BM + wc * 64) * 2;
            rope_rows<128, 2560, 64>(acc, rs, pf + 256 + wc * 32 + 8 * fq, tu, (unsigned)(fq * 512 + fr * 16), ou, (unsigned)(fr * 2560 + 8 * fq) * 2u);
        } else {
            const int col0 = u.pn * BM + wc * 32 + 8 * fq;
#pragma unroll
            for (int ai = 0; ai < 2; ++ai)
#pragma unroll
                for (int m = 0; m < 4; ++m) { bf16_t* rowp = O + (size_t)(row0 + ai * HALF + m * 16) * 2560 + col0;
#pragma unroll
                    for (int bj = 0; bj < 2; ++bj) { const f32x4 v0 = acc[ai][bj][m][0] * rs[ai][m] + bb[bj][0], v1 = acc[ai][bj][m][1] * rs[ai][m] + bb[bj][1];
                        u32x4 w; w.x = cvt_pk_bf16(v0[0], v0[1]); w.y = cvt_pk_bf16(v0[2], v0[3]); w.z = cvt_pk_bf16(v1[0], v1[1]); w.w = cvt_pk_bf16(v1[2], v1[3]);
                        *(u32x4*)(rowp + bj * HALF) = w; } }
        }
    }
};
struct EpiFfnIn {
    static constexpr bool PERM = true, AFTER_DRAIN = false, F16 = XA_F16;
    bf16_t* O; const float* ss; const float* bias0; PG8_LAS float* pf;
    __device__ __forceinline__ float prefetch(const Unit& u, int tid) const { if (tid < 256) { const float* p = ss + u.pm * BM + tid; float a = p[0];
#pragma unroll
            for (int j = 1; j < 8; ++j) a += p[(size_t)j * SS_PSTRIDE]; return a; }
        return bias0[(u.pm >= (SEQ_LEN / BM) ? BIAS_BSTRIDE : 0) + u.pn * BM + (tid - 256)]; }
    __device__ __forceinline__ void operator()(const f32x4 (&acc)[2][2][4][2], const Unit& u, int wr, int wc, int fr_, int fq_, float epre) const {
        int lane_; asm volatile("v_mbcnt_lo_u32_b32 %0, -1, 0\n\tv_mbcnt_hi_u32_b32 %0, -1, %0" : "=v"(lane_)); const int fr = lane_ & 15, fq = lane_ >> 4; (void)fr_; (void)fq_;
        const int row0 = u.pm * BM + wr * 64 + fr; const int col0 = u.pn * HALF + 32 * wc + 8 * fq;
        pf[(wr * 4 + wc) * 64 + lane_] = epre;
        asm volatile("s_waitcnt lgkmcnt(0)" ::: "memory"); __builtin_amdgcn_s_barrier(); asm volatile("" ::: "memory");
        float rs[2][4];
#pragma unroll
        for (int ai = 0; ai < 2; ++ai)
#pragma unroll
            for (int m = 0; m < 4; ++m) rs[ai][m] = __builtin_amdgcn_rsqf(pf[ai * HALF + wr * 64 + m * 16 + fr] * INV_DM + NORM_EPS);
        f32x4 bb[2][2];
#pragma unroll
        for (int bj = 0; bj < 2; ++bj)
#pragma unroll
            for (int n = 0; n < 2; ++n) bb[bj][n] = *(const PG8_LAS f32x4*)(pf + 256 + bj * HALF + wc * 32 + 8 * fq + 4 * n);
#pragma unroll
        for (int ai = 0; ai < 2; ++ai)
#pragma unroll
            for (int m = 0; m < 4; ++m) { bf16_t* rowp = O + (size_t)(row0 + ai * HALF + m * 16) * 5632 + col0; u32x4 w;
#pragma unroll
                for (int n = 0; n < 2; ++n) { const f32x4 g = acc[ai][0][m][n] * rs[ai][m] + bb[0][n], up = acc[ai][1][m][n] * rs[ai][m] + bb[1][n]; f32x4 h;
#pragma unroll
                    for (int i = 0; i < 4; ++i) { const float ex = __builtin_amdgcn_exp2f(g[i] * -1.4426950408889634f); h[i] = g[i] * __builtin_amdgcn_rcpf(1.0f + ex) * up[i]; }
                    const u32x2 pk = pack4(h); if (n == 0) { w.x = pk.x; w.y = pk.y; } else { w.z = pk.x; w.w = pk.y; } }
                *(u32x4*)rowp = w; }
    }
};
__device__ __forceinline__ int quad_tr_src(int lane) { return ((lane & 0x0c) | ((lane & 3) << 4) | ((lane >> 4) & 3)) << 2; }
__device__ __forceinline__ u32x4 quad_tr(u32x4 w, int srcb) { u32x4 r; r.x = (unsigned)__builtin_amdgcn_ds_bpermute(srcb, (int)w.x); r.y = (unsigned)__builtin_amdgcn_ds_bpermute(srcb, (int)w.y);
    r.z = (unsigned)__builtin_amdgcn_ds_bpermute(srcb, (int)w.z); r.w = (unsigned)__builtin_amdgcn_ds_bpermute(srcb, (int)w.w); return r; }
__device__ __forceinline__ f32x4 sigma4(f32x4 sc) { f32x4 r;
#pragma unroll
    for (int i = 0; i < 4; ++i) { const float v = 1.0f + sc[i]; r[i] = __builtin_fabsf(v) < 1e-20f ? __builtin_copysignf(1e-20f, v) : v; }
    return r; }
template <bool BASEF32, bool HAS_NEXT> struct EpiResidH {
    static constexpr bool PERM = true, AFTER_DRAIN = false, F16 = false;
    const void* base; bf16_t* xa; bf16_t* xfin; const float* gate0; const float* bias; const float* scp0; const float* scn0; float* ssn; PG8_LAS float* red;
    __device__ __forceinline__ float prefetch(const Unit&, int) const { return 0.f; }
    __device__ __forceinline__ void operator()(const f32x4 (&acc)[2][2][4][2], const Unit& u, int wr, int wc, int fr_, int fq_, float) const {
        int lane_; asm volatile("v_mbcnt_lo_u32_b32 %0, -1, 0\n\tv_mbcnt_hi_u32_b32 %0, -1, %0" : "=v"(lane_));
        const int fr = lane_ & 15, fq = lane_ >> 4; (void)fr_; (void)fq_;
        const int bo = u.pm >= (SEQ_LEN / BM) ? 12288 : 0;
        float s2a[2][4];
#pragma unroll
        for (int ai = 0; ai < 2; ++ai)
#pragma unroll
            for (int m = 0; m < 4; ++m) s2a[ai][m] = 0.f;
        constexpr int NR = 2;
        constexpr int NLD = 2, NST = 2;
        const size_t uoff = (size_t)(u.pm * BM + wr * 64) * 2048 + u.pn * BM + wc * 32;
        const unsigned vo2 = (unsigned)(fr * 2048 + 8 * fq) * 2u, vo4 = vo2 * 2u, vv = (unsigned)fq * 32u;
        const unsigned vo2n = (unsigned)(((fr & 12) | fq) * 2048 + 8 * (fr & 3)) * 2u;
        const int srcb = quad_tr_src(lane_);
        const char* b_u = (const char*)base + uoff * (BASEF32 ? 4 : 2); const char* xa_u = (const char*)xa + uoff * 2; const char* xf_u = (const char*)xfin + uoff * 2;
        const char* g_u = (const char*)(gate0 + bo + u.pn * BM + wc * 32); const char* bi_u = (const char*)(bias + u.pn * BM + wc * 32);
        const char* sp_u = (const char*)(scp0 + bo + u.pn * BM + wc * 32); const char* sc_u = (const char*)(scn0 + bo + u.pn * BM + wc * 32);
        u32x4 hb0[2], hb1[2]; f32x4 fb0[2][2], fb1[2][2];
        f32x4 gv[2], bv[2], sv[2], rp[2];
#define RH_ROFF(ai_, m_, bj_) ((size_t)((ai_) * HALF + (m_) * 16) * 2048 + (bj_) * HALF)
#define RH_LOAD(HB, FB, k) do { const int bj_ = (k) / (8 / NR), ai_ = ((k) / (4 / NR)) & 1, mb_ = ((k) % (4 / NR)) * NR; _Pragma("unroll") for (int m = mb_; m < mb_ + NR; ++m) { \
            if constexpr (BASEF32) { const char* p_ = b_u + RH_ROFF(ai_, m, bj_) * 4; FB[m & (NR - 1)][0] = *(const f32x4*)(p_ + vo4); FB[m & (NR - 1)][1] = *(const f32x4*)(p_ + 16 + vo4); } \
            else HB[m & (NR - 1)] = *(const u32x4*)(b_u + RH_ROFF(ai_, m, bj_) * 2 + vo2n); } } while (0)
#define RH_PIN(HB, FB) do { if constexpr (BASEF32) asm volatile("" : "+v"(FB[0][0]), "+v"(FB[0][1]), "+v"(FB[1][0]), "+v"(FB[1][1]) :: "memory"); \
            else asm volatile("" : "+v"(HB[0]), "+v"(HB[1]) :: "memory"); } while (0)
#define RH_BODY(HB, FB, k) do { const int bj = (k) / (8 / NR), ai = ((k) / (4 / NR)) & 1, mb = ((k) % (4 / NR)) * NR; \
            if (((k) % (8 / NR)) == 0) { _Pragma("unroll") for (int n = 0; n < 2; ++n) { gv[n] = *(const f32x4*)(g_u + (bj * HALF + n * 4) * 4 + vv); bv[n] = bias ? *(const f32x4*)(bi_u + (bj * HALF + n * 4) * 4 + vv) : (f32x4){0.f, 0.f, 0.f, 0.f}; \
                if constexpr (HAS_NEXT) sv[n] = sigma4(*(const f32x4*)(sc_u + (bj * HALF + n * 4) * 4 + vv)); \
                if constexpr (!BASEF32) { const f32x4 sp = sigma4(*(const f32x4*)(sp_u + (bj * HALF + n * 4) * 4 + vv)); \
                    rp[n] = (f32x4){__builtin_amdgcn_rcpf(sp[0]), __builtin_amdgcn_rcpf(sp[1]), __builtin_amdgcn_rcpf(sp[2]), __builtin_amdgcn_rcpf(sp[3])}; } } } \
            _Pragma("unroll") for (int m = mb; m < mb + NR; ++m) { const size_t ro = RH_ROFF(ai, m, bj) * 2; f32x4 b0, b1; \
                if constexpr (BASEF32) { b0 = FB[m & (NR - 1)][0]; b1 = FB[m & (NR - 1)][1]; } \
                else { const u32x4 hb = quad_tr(HB[m & (NR - 1)], srcb); \
                    b0 = (f32x4){__uint_as_float(hb.x << 16), __uint_as_float(hb.x & 0xffff0000u), __uint_as_float(hb.y << 16), __uint_as_float(hb.y & 0xffff0000u)} * rp[0]; \
                    b1 = (f32x4){__uint_as_float(hb.z << 16), __uint_as_float(hb.z & 0xffff0000u), __uint_as_float(hb.w << 16), __uint_as_float(hb.w & 0xffff0000u)} * rp[1]; } \
                const f32x4 x0 = b0 + gv[0] * (acc[ai][bj][m][0] + bv[0]), x1 = b1 + gv[1] * (acc[ai][bj][m][1] + bv[1]); \
                s2a[ai][m] += ((x0[0] * x0[0] + x0[1] * x0[1]) + (x0[2] * x0[2] + x0[3] * x0[3])) + ((x1[0] * x1[0] + x1[1] * x1[1]) + (x1[2] * x1[2] + x1[3] * x1[3])); \
                if constexpr (HAS_NEXT) { const u32x2 lo = pack4(x0 * sv[0]), hi = pack4(x1 * sv[1]); *(u32x4*)(const_cast<char*>(xa_u) + ro + vo2n) = quad_tr((u32x4){lo.x, lo.y, hi.x, hi.y}, srcb); }     \
                else { const u32x2 lo = pack4h(x0), hi = pack4h(x1); *(u32x4*)(const_cast<char*>(xf_u) + ro + vo2) = (u32x4){lo.x, lo.y, hi.x, hi.y}; } } \
            asm volatile("" ::: "memory"); } while (0)
        if constexpr (BASEF32) {
#pragma unroll
            for (int k = 0; k < 8; ++k) { RH_LOAD(hb0, fb0, k); asm volatile("s_waitcnt vmcnt(0)" ::: "memory"); RH_PIN(hb0, fb0); RH_BODY(hb0, fb0, k); }
        } else {
        RH_LOAD(hb0, fb0, 0); asm volatile("" ::: "memory");
        RH_LOAD(hb1, fb1, 1); asm volatile("s_waitcnt vmcnt(%0)" :: "n"(NLD) : "memory"); RH_PIN(hb0, fb0);
        RH_BODY(hb0, fb0, 0);
#define RH_STEP(HBa, FBa, HBb, FBb, k) do { RH_LOAD(HBa, FBa, (k) + 1); asm volatile("s_waitcnt vmcnt(%0)" :: "n"(NLD + NST) : "memory"); RH_PIN(HBb, FBb); RH_BODY(HBb, FBb, k); } while (0)
        RH_STEP(hb0, fb0, hb1, fb1, 1); RH_STEP(hb1, fb1, hb0, fb0, 2); RH_STEP(hb0, fb0, hb1, fb1, 3); RH_STEP(hb1, fb1, hb0, fb0, 4); RH_STEP(hb0, fb0, hb1, fb1, 5); RH_STEP(hb1, fb1, hb0, fb0, 6);
#undef RH_STEP
        asm volatile("s_waitcnt vmcnt(%0)" :: "n"(NST) : "memory"); RH_PIN(hb1, fb1);
        RH_BODY(hb1, fb1, 7);
        }
#undef RH_ROFF
#undef RH_LOAD
#undef RH_PIN
#undef RH_BODY
#pragma unroll
        for (int ai = 0; ai < 2; ++ai)
#pragma unroll
            for (int m = 0; m < 4; ++m) { float s2 = s2a[ai][m]; s2 += xl_xor(s2, lane_, 16); s2 += xl_xor(s2, lane_, 32);
                if (fq == 0) red[wc * 256 + ai * HALF + wr * 64 + m * 16 + fr] = s2; }
        asm volatile("s_waitcnt lgkmcnt(0)" ::: "memory"); __builtin_amdgcn_s_barrier(); asm volatile("" ::: "memory");
        if (wc == 0) { const int l = lane_;
#pragma unroll
            for (int ai = 0; ai < 2; ++ai) { const int idx = ai * HALF + wr * 64 + l; const float v = (red[idx] + red[256 + idx]) + (red[512 + idx] + red[768 + idx]);
                if (ssn) ssn[(size_t)u.pn * SS_PSTRIDE + u.pm * BM + idx] = v; } }
    }
};
template <class Epi, class Sched, bool ALIGN_EPI = false, bool SP2 = false>
__device__ __forceinline__ void gemm_phase(PG8_LAS unsigned char* lds, const Gemm g, const Sched& S, const Epi& E, const int wv) {
    int lane; asm volatile("v_mbcnt_lo_u32_b32 %0, -1, 0\n\tv_mbcnt_hi_u32_b32 %0, -1, %0" : "=v"(lane));
    const int wid = wv, tid = wv * 64 + lane, wr = wid >> 2, wc = wid & 3, fr = lane & 15, fq = lane >> 4;
    const int K = g.K, nt = K / BK;
    unsigned voffA[2], voffB[2];
#pragma unroll
    for (int i = 0; i < 2; ++i) { int R, C; stage_rc(tid * 16 + i * 8192, R, C); const int Rb = Epi::PERM ? ((R & ~31) + perm32(R & 31)) : R;
        voffA[i] = (unsigned)(R * K + C) * 2u; voffB[i] = (unsigned)(Rb * K + C) * 2u; }
    const size_t kstep = (size_t)(BK * 2);
    const size_t hstep = (size_t)HALF * K * 2;
    const size_t tstep = 2 * hstep;
    const unsigned ldsw = (unsigned)wid * 1024u;
    const int aoff = lds_byte(wr * 64 + fr, fq * 8), boff = lds_byte(wc * 32 + fr, fq * 8);
#define PG8_SA(b, h) (((b) * 2 + (h)) * HTB)
#define PG8_SB(b, h) ((4 + (b) * 2 + (h)) * HTB)
#define PG8_STAGE(bufoff, gbase, voff) do { _Pragma("unroll") for (int _i = 0; _i < 2; ++_i) \
        __builtin_amdgcn_global_load_lds((const unsigned*)((const char*)(gbase) + (voff)[_i]), (PG8_LAS unsigned*)(lds + (bufoff) + ldsw + _i * 8192), 16, 0, 0); } while (0)
#define PG8_LDA(dst, b, h) do { _Pragma("unroll") for (int m = 0; m < 4; ++m) _Pragma("unroll") for (int k = 0; k < 2; ++k) dst[m][k] = *(const PG8_LAS bf16x8*)(lds + PG8_SA(b, h) + aoff + m * 2048 + k * 1024); } while (0)
#define PG8_LDB(dst, b, h) do { _Pragma("unroll") for (int n = 0; n < 2; ++n) _Pragma("unroll") for (int k = 0; k < 2; ++k) dst[n][k] = *(const PG8_LAS bf16x8*)(lds + PG8_SB(b, h) + boff + n * 2048 + k * 1024); } while (0)
#define PG8_MMA(ai, bj, At, Bt) do { __builtin_amdgcn_s_setprio(1); _Pragma("unroll") for (int m = 0; m < 4; ++m) _Pragma("unroll") for (int n = 0; n < 2; ++n) _Pragma("unroll") for (int k = 0; k < 2; ++k) \
        acc[ai][bj][m][n] = mma16<Epi::F16>(Bt[n][k], At[m][k], acc[ai][bj][m][n]); __builtin_amdgcn_s_setprio(0); } while (0)
#define PG8_WAIT_V(n) asm volatile("s_waitcnt vmcnt(" #n ")" ::: "memory")
#define PG8_WAIT_L(n) asm volatile("s_waitcnt lgkmcnt(" #n ")" ::: "memory")
#define PG8_BAR __builtin_amdgcn_s_barrier()
#define PG8_SCHED __builtin_amdgcn_sched_barrier(0)
    Unit cur, nxt; int ui = 0;
    if (!S.next(0, cur)) return;
    f32x4 acc[2][2][4][2];
#pragma unroll
    for (int a = 0; a < 2; ++a)
#pragma unroll
        for (int b = 0; b < 2; ++b)
#pragma unroll
            for (int m = 0; m < 4; ++m)
#pragma unroll
                for (int n = 0; n < 2; ++n) acc[a][b][m][n] = (f32x4){0.f, 0.f, 0.f, 0.f};
    bf16x8 At[4][2], B0[2][2], B1[2][2];
    const char* cA = (const char*)g.A + (size_t)cur.pm * tstep; const char* cB = (const char*)g.Bt + (size_t)cur.pn * tstep;
    S.a_ready(cur);
    float epre = E.prefetch(cur, tid);
    if constexpr (SP2) {
        PG8_STAGE(PG8_SB(0, 0), cB, voffB); PG8_STAGE(PG8_SB(0, 1), cB + hstep, voffB); PG8_STAGE(PG8_SA(0, 0), cA, voffA); PG8_STAGE(PG8_SA(0, 1), cA + hstep, voffA);
        if (wr == 1) PG8_BAR;
        PG8_WAIT_V(2); PG8_BAR;
        PG8_STAGE(PG8_SB(1, 0), cB + kstep, voffB); PG8_STAGE(PG8_SA(1, 0), cA + kstep, voffA); PG8_STAGE(PG8_SB(1, 1), cB + hstep + kstep, voffB);
        PG8_WAIT_V(6); PG8_BAR;
    } else {
        PG8_STAGE(PG8_SB(0, 0), cB, voffB); PG8_STAGE(PG8_SA(0, 0), cA, voffA); PG8_STAGE(PG8_SB(0, 1), cB + hstep, voffB); PG8_STAGE(PG8_SA(0, 1), cA + hstep, voffA);
        if (wr == 1) PG8_BAR;
        PG8_WAIT_V(4); PG8_BAR;
        PG8_STAGE(PG8_SB(1, 0), cB + kstep, voffB); PG8_STAGE(PG8_SA(1, 0), cA + kstep, voffA); PG8_STAGE(PG8_SB(1, 1), cB + hstep + kstep, voffB);
        PG8_WAIT_V(6); PG8_BAR;
    }
    for (;;) {
        const bool has_next = S.next(ui + 1, nxt);
        const char* nA = has_next ? (const char*)g.A + (size_t)nxt.pm * tstep : cA; const char* nB = has_next ? (const char*)g.Bt + (size_t)nxt.pn * tstep : cB;
        for (int t = 0; t < nt; t += 2) {
            const bool last = (t == nt - 2);
            const char* a1 = cA + (size_t)(t + 1) * kstep;
            const char* a2 = last ? nA : cA + (size_t)(t + 2) * kstep; const char* b2 = last ? nB : cB + (size_t)(t + 2) * kstep;
            const char* a3 = a2 + kstep; const char* b3 = b2 + kstep;
            if (last && has_next) S.a_ready(nxt);
            if constexpr (SP2) {
            PG8_LDB(B0, 0, 0); PG8_LDB(B1, 0, 1); PG8_SCHED; PG8_LDA(At, 0, 0); PG8_STAGE(PG8_SA(1, 1), a1 + hstep, voffA);
            PG8_WAIT_V(8); PG8_WAIT_L(0); PG8_BAR; PG8_MMA(0, 0, At, B0); PG8_MMA(0, 1, At, B1); PG8_BAR; PG8_SCHED;
            PG8_LDA(At, 0, 1); PG8_STAGE(PG8_SB(0, 0), b2, voffB); PG8_STAGE(PG8_SB(0, 1), b2 + hstep, voffB); PG8_STAGE(PG8_SA(0, 0), a2, voffA);
            PG8_WAIT_V(8); PG8_WAIT_L(0); PG8_BAR; PG8_MMA(1, 0, At, B0); PG8_MMA(1, 1, At, B1); PG8_BAR; PG8_SCHED;
            PG8_LDB(B0, 1, 0); PG8_LDB(B1, 1, 1); PG8_SCHED; PG8_LDA(At, 1, 0); PG8_STAGE(PG8_SA(0, 1), a2 + hstep, voffA);
            PG8_WAIT_V(8); PG8_WAIT_L(0); PG8_BAR; PG8_MMA(0, 0, At, B0); PG8_MMA(0, 1, At, B1); PG8_BAR; PG8_SCHED;
            PG8_LDA(At, 1, 1); PG8_STAGE(PG8_SB(1, 0), b3, voffB); PG8_STAGE(PG8_SB(1, 1), b3 + hstep, voffB); PG8_STAGE(PG8_SA(1, 0), a3, voffA);
            PG8_WAIT_V(8); PG8_WAIT_L(0); PG8_BAR; PG8_MMA(1, 0, At, B0); PG8_MMA(1, 1, At, B1); PG8_BAR; PG8_SCHED;
            } else {
            PG8_LDB(B0, 0, 0); PG8_SCHED; PG8_LDA(At, 0, 0); PG8_STAGE(PG8_SA(1, 1), a1 + hstep, voffA);
            PG8_WAIT_L(8); PG8_BAR; PG8_WAIT_L(0); PG8_MMA(0, 0, At, B0); PG8_BAR; PG8_SCHED;
            PG8_LDB(B1, 0, 1); PG8_STAGE(PG8_SB(0, 0), b2, voffB);
            PG8_BAR; PG8_WAIT_L(0); PG8_MMA(0, 1, At, B1); PG8_BAR;
            PG8_LDA(At, 0, 1); PG8_STAGE(PG8_SA(0, 0), a2, voffA);
            PG8_BAR; PG8_WAIT_L(0); PG8_MMA(1, 0, At, B0); PG8_BAR; PG8_SCHED;
            PG8_STAGE(PG8_SB(0, 1), b2 + hstep, voffB);
            PG8_WAIT_V(6); PG8_BAR; PG8_MMA(1, 1, At, B1); PG8_BAR;
            PG8_LDB(B0, 1, 0); PG8_SCHED; PG8_LDA(At, 1, 0); PG8_STAGE(PG8_SA(0, 1), a2 + hstep, voffA);
            PG8_WAIT_L(8); PG8_BAR; PG8_WAIT_L(0); PG8_MMA(0, 0, At, B0); PG8_BAR; PG8_SCHED;
            PG8_LDB(B1, 1, 1); PG8_STAGE(PG8_SB(1, 0), b3, voffB);
            PG8_BAR; PG8_WAIT_L(0); PG8_MMA(0, 1, At, B1); PG8_BAR;
            PG8_LDA(At, 1, 1); PG8_STAGE(PG8_SA(1, 0), a3, voffA);
            PG8_BAR; PG8_WAIT_L(0); PG8_MMA(1, 0, At, B0); PG8_BAR; PG8_SCHED;
            PG8_STAGE(PG8_SB(1, 1), b3 + hstep, voffB);
            PG8_WAIT_V(6); PG8_BAR; PG8_MMA(1, 1, At, B1); PG8_BAR;
            }
        }
        if constexpr (ALIGN_EPI) { if (wr == 0) PG8_BAR; }
        if constexpr (!Epi::AFTER_DRAIN) { E(acc, cur, wr, wc, fr, fq, epre); S.done(cur); }
        if (!has_next) break;
#pragma unroll
        for (int a = 0; a < 2; ++a)
#pragma unroll
            for (int b = 0; b < 2; ++b)
#pragma unroll
                for (int m = 0; m < 4; ++m)
#pragma unroll
                    for (int n = 0; n < 2; ++n) acc[a][b][m][n] = (f32x4){0.f, 0.f, 0.f, 0.f};
        cur = nxt; cA = nA; cB = nB; ++ui;
        epre = E.prefetch(cur, tid);
        if constexpr (ALIGN_EPI) { if (wr == 1) PG8_BAR; }
    }
    PG8_WAIT_V(0);
    if constexpr (!ALIGN_EPI) { if (wr == 0) PG8_BAR; }
    PG8_BAR;
    if constexpr (Epi::AFTER_DRAIN) { E.fused(acc, cur, wr, wc, fr, fq, lds, wid, lane); S.done(cur); }
#undef PG8_SA
#undef PG8_SB
#undef PG8_STAGE
#undef PG8_LDA
#undef PG8_LDB
#undef PG8_MMA
#undef PG8_WAIT_V
#undef PG8_WAIT_L
#undef PG8_BAR
#undef PG8_SCHED
}
}

namespace att {
typedef unsigned short bf16_t;
typedef short bf16x8 __attribute__((ext_vector_type(8)));
typedef short s16x4 __attribute__((ext_vector_type(4)));
typedef float f32x16 __attribute__((ext_vector_type(16)));
typedef float f32x4 __attribute__((ext_vector_type(4)));
typedef unsigned u32x4 __attribute__((ext_vector_type(4)));
constexpr int D = 128;
constexpr float SCALE = 0.08838834764831845f;
constexpr float THR = 8.f;
constexpr int NW = 8, QBLK = 32, KVBLK = 64, QB = NW * QBLK;
constexpr int SHM_V = KVBLK * D * 2, SHM_K = KVBLK * D * 2;
constexpr int LDS_BYTES = 2 * SHM_V + 2 * SHM_K + NW * 64 * 4;

#define KSWZ(row, colB) ((row) * 256 + ((colB) ^ (((row) & 7) << 4)))
#define SBAR() __builtin_amdgcn_sched_barrier(0)
__device__ __forceinline__ int v_st(int k, int c) { const int kk = (k & ~0xC) | ((k & 4) << 1) | ((k & 8) >> 1); return ((kk >> 3) * 4 + (c >> 5)) * 512 + ((kk & 7) * 32 + (c & 31)) * 2; }
__device__ __forceinline__ int v_rd_base(int lane) { return ((lane & 3) << 3) | (((lane >> 2) & 3) << 6) | (((lane >> 4) & 1) << 5) | (((lane >> 5) & 1) << 8); }
constexpr int v_rd_off(int d0, int ks, int half) { return d0 * 512 + ks * 4096 + half * 2048; }
__device__ __forceinline__ int crow(int r, int hi) { return (r & 3) + 8 * (r >> 2) + 4 * hi; }
__device__ __forceinline__ unsigned cvtpk(float lo, float hi) { unsigned r; asm volatile("v_cvt_pk_bf16_f32 %0, %1, %2" : "=v"(r) : "v"(lo), "v"(hi)); return r; }
__device__ __forceinline__ bf16x8 load8(const bf16_t* p) { return *reinterpret_cast<const bf16x8*>(p); }
__device__ __forceinline__ void mask_tile(f32x16& p0, f32x16& p1, int dq, unsigned W) {
    const float NEG = -__builtin_inff();
#pragma unroll
    for (int r = 0; r < 16; ++r) {
        const int c = (r & 3) + 8 * (r >> 2);
        if ((unsigned)(dq - c) >= W) p0[r] = NEG;
        if ((unsigned)(dq - c - 32) >= W) p1[r] = NEG;
    }
}
__device__ __forceinline__ void mask_all(f32x16& p0, f32x16& p1, bool kill) {
    const float NEG = -__builtin_inff();
#pragma unroll
    for (int r = 0; r < 16; ++r) { if (kill) p0[r] = NEG; if (kill) p1[r] = NEG; }
}
__device__ __forceinline__ void partialSM(f32x16& p0, f32x16& p1, float& m_reg, float& mn, float& alpha) {
    float pmax = p0[0]; for (int r = 1; r < 16; ++r) pmax = fmaxf(pmax, p0[r]); for (int r = 0; r < 16; ++r) pmax = fmaxf(pmax, p1[r]);
    { auto rr = __builtin_amdgcn_permlane32_swap(__float_as_uint(pmax), __float_as_uint(pmax), false, false);
      pmax = fmaxf(__uint_as_float(rr[0]), __uint_as_float(rr[1])); }
    constexpr float C2 = 1.4426950408889634f * SCALE;
    if (__builtin_expect(__all((pmax - m_reg) * SCALE <= THR), 1)) { mn = m_reg; alpha = 1.f; }
    else { mn = fmaxf(m_reg, pmax); alpha = __builtin_amdgcn_exp2f((m_reg - mn) * C2); m_reg = mn; }
    const float mnL = -mn * C2;
    for (int r = 0; r < 16; ++r) p0[r] = fmaf(p0[r], C2, mnL); for (int r = 0; r < 16; ++r) p1[r] = fmaf(p1[r], C2, mnL);
    for (int r = 0; r < 16; ++r) p0[r] = __builtin_amdgcn_exp2f(p0[r]);
}
__device__ __forceinline__ void finishSM(f32x16& p0, f32x16& p1, float alpha, float& l_reg, bf16x8& pa0, bf16x8& pa1, bf16x8& pa2, bf16x8& pa3) {
    for (int r = 0; r < 16; ++r) p1[r] = __builtin_amdgcn_exp2f(p1[r]);
    float ps = 0; for (int r = 0; r < 16; ++r) ps += p0[r]; for (int r = 0; r < 16; ++r) ps += p1[r];
    { auto rr = __builtin_amdgcn_permlane32_swap(__float_as_uint(ps), __float_as_uint(ps), false, false);
      ps = __uint_as_float(rr[0]) + __uint_as_float(rr[1]); }
    l_reg = l_reg * alpha + ps;
#define PK4(P, B_, OUT) do { unsigned a0 = cvtpk(P[B_+0], P[B_+1]), a1 = cvtpk(P[B_+2], P[B_+3]);                          \
        unsigned b0 = cvtpk(P[B_+4], P[B_+5]), b1 = cvtpk(P[B_+6], P[B_+7]);                                             \
        auto r0 = __builtin_amdgcn_permlane32_swap(a0, b0, false, false); auto r1 = __builtin_amdgcn_permlane32_swap(a1, b1, false, false); \
        u32x4 w = {r0[0], r1[0], r0[1], r1[1]}; OUT = *reinterpret_cast<bf16x8*>(&w); } while (0)
    PK4(p0, 0, pa0); PK4(p0, 8, pa1); PK4(p1, 0, pa2); PK4(p1, 8, pa3);
#undef PK4
}
template <int KB>
__device__ __forceinline__ void qkt(f32x16& p0, f32x16& p1, const char* K_lds, int r32, int hi, const bf16x8* qr) {
    p0 = f32x16{}; p1 = f32x16{};
    unsigned kb[4];
#pragma unroll
    for (int dd = 0; dd < 4; ++dd) kb[dd] = (unsigned)(uintptr_t)K_lds + KB * SHM_K + KSWZ(r32, (dd * 16 + hi * 8) * 2);
#define KRD(dst, i) asm volatile("ds_read_b128 %0, %1 offset:%2" : "=&v"(dst) : "v"(kb[((i) >> 1) & 3]), "i"((((i) >> 1) >> 2) * 128 + ((i) & 1) * 8192) : "memory")
#define KMMA(f, i) do { if (((i) & 1) == 0) p0 = __builtin_amdgcn_mfma_f32_32x32x16_bf16(f, qr[(i) >> 1], p0, 0, 0, 0); else p1 = __builtin_amdgcn_mfma_f32_32x32x16_bf16(f, qr[(i) >> 1], p1, 0, 0, 0); } while (0)
#define KW(n) do { asm volatile("s_waitcnt lgkmcnt(" #n ")" ::: "memory"); SBAR(); } while (0)
    bf16x8 f0, f1, f2;
    KRD(f0, 0); KRD(f1, 1);
#define K3(i) do { KRD(f2, (i) + 2); KW(2); KMMA(f0, i); SBAR(); KRD(f0, (i) + 3); KW(2); KMMA(f1, (i) + 1); SBAR(); KRD(f1, (i) + 4); KW(2); KMMA(f2, (i) + 2); SBAR(); } while (0)
    K3(0); K3(3); K3(6); K3(9);
    KRD(f2, 14); KW(2); KMMA(f0, 12); SBAR(); KRD(f0, 15); KW(2); KMMA(f1, 13); SBAR(); KW(1); KMMA(f2, 14); SBAR(); KW(0); KMMA(f0, 15);
#undef K3
#undef KW
#undef KMMA
#undef KRD
}
template <int VB>
__device__ __forceinline__ void pv_tile(f32x16* o, int vb0, bf16x8 pa0, bf16x8 pa1, bf16x8 pa2, bf16x8 pa3) {
#define TRRD(dst, off) asm volatile("ds_read_b64_tr_b16 %0, %1 offset:%2" : "=&v"(dst) : "v"(vb0), "i"(off) : "memory")
#define LDA(d0) do { constexpr int b_ = VB * SHM_V + v_rd_off(d0, 0, 0); TRRD(l0, b_); TRRD(h0, b_ + 2048); TRRD(l1, b_ + 4096); TRRD(h1, b_ + 6144); } while (0)
#define LDB(d0) do { constexpr int b_ = VB * SHM_V + v_rd_off(d0, 0, 0); TRRD(l2, b_ + 8192); TRRD(h2, b_ + 10240); TRRD(l3, b_ + 12288); TRRD(h3, b_ + 14336); } while (0)
#define MMA01(d0) do { \
        o[d0] = __builtin_amdgcn_mfma_f32_32x32x16_bf16(pa0, (bf16x8){l0[0], l0[1], l0[2], l0[3], h0[0], h0[1], h0[2], h0[3]}, o[d0], 0, 0, 0);   \
        o[d0] = __builtin_amdgcn_mfma_f32_32x32x16_bf16(pa1, (bf16x8){l1[0], l1[1], l1[2], l1[3], h1[0], h1[1], h1[2], h1[3]}, o[d0], 0, 0, 0); } while (0)
#define MMA23(d0) do { \
        o[d0] = __builtin_amdgcn_mfma_f32_32x32x16_bf16(pa2, (bf16x8){l2[0], l2[1], l2[2], l2[3], h2[0], h2[1], h2[2], h2[3]}, o[d0], 0, 0, 0);   \
        o[d0] = __builtin_amdgcn_mfma_f32_32x32x16_bf16(pa3, (bf16x8){l3[0], l3[1], l3[2], l3[3], h3[0], h3[1], h3[2], h3[3]}, o[d0], 0, 0, 0); } while (0)
#define W4() do { asm volatile("s_waitcnt lgkmcnt(4)" ::: "memory"); SBAR(); } while (0)
#define W0() do { asm volatile("s_waitcnt lgkmcnt(0)" ::: "memory"); SBAR(); } while (0)
    s16x4 l0, l1, l2, l3, h0, h1, h2, h3;
    LDA(0);
#define STEP(d0) do { LDB(d0); W4(); MMA01(d0); SBAR(); LDA((d0) + 1); W4(); MMA23(d0); SBAR(); } while (0)
    STEP(0); STEP(1); STEP(2);
    LDB(3); W4(); MMA01(3); SBAR(); W0(); MMA23(3);
#undef STEP
#undef W0
#undef W4
#undef MMA23
#undef MMA01
#undef LDB
#undef LDA
#undef TRRD
}

struct BlockRef { const bf16_t* Q; const bf16_t* K; const bf16_t* V; bf16_t* O; const unsigned long long* RM; int P0; };
struct Seam { bf16x8 qr[8]; bf16x8 st_v0, st_v1, st_k0, st_k1; };
#define VMW() asm volatile("s_waitcnt vmcnt(0)" ::: "memory")
#define VMWN(n) asm volatile("s_waitcnt vmcnt(%0)" :: "i"(n) : "memory")
#define SLOAD_H(Kp, Vp, k0) do { const char* kt_ = (const char*)(Kp) + (size_t)(k0) * (LD * 2); const char* vt_ = (const char*)(Vp) + (size_t)(k0) * (LD * 2);              \
                         S.st_v0 = *(const bf16x8*)(vt_ + voff); S.st_v1 = *(const bf16x8*)(vt_ + 32 * LD * 2 + voff);              \
                         S.st_k0 = *(const bf16x8*)(kt_ + voff); S.st_k1 = *(const bf16x8*)(kt_ + 32 * LD * 2 + voff); } while (0)
#define SWRITE_HK(bf) do { *(bf16x8*)(K_lds + (bf) * SHM_K + kws) = S.st_k0; *(bf16x8*)(K_lds + (bf) * SHM_K + kws + 32 * 256) = S.st_k1; } while (0)
#define SWRITE_HV(bf) do { *(bf16x8*)(V_lds + (bf) * SHM_V + vst0) = S.st_v0; *(bf16x8*)(V_lds + (bf) * SHM_V + vst1) = S.st_v1; } while (0)
#define SWRITE_H(bf) do { SWRITE_HV(bf); SWRITE_HK(bf); } while (0)
template <int LD>
__device__ __forceinline__ void causal_prime(const BlockRef& cur, char* lds, Seam& S, const int tid) {
    const int wid = __builtin_amdgcn_readfirstlane(tid >> 6), lane = tid & 63, r32 = lane & 31, hi = lane >> 5;
    const int sr = tid >> 4, sc = (tid & 15) * 8, kws = KSWZ(sr, sc * 2); char* K_lds = lds + 2 * SHM_V;
    const unsigned voff = (unsigned)(sr * LD + sc) * 2u, qoff = (unsigned)(r32 * LD + hi * 8) * 2u;
    { const char* qb_ = (const char*)cur.Q + (size_t)(wid * QBLK) * (LD * 2);
      for (int d0 = 0; d0 < 8; ++d0) S.qr[d0] = *(const bf16x8*)(qb_ + qoff + d0 * 32); }
    SLOAD_H(cur.K, cur.V, 0); VMW(); SWRITE_HK(0);
    __syncthreads();
}
template <int LD, int LDO, bool MOBA>
__device__ __forceinline__ void causal_block(const BlockRef& cur, const BlockRef& nxt, char* lds, Seam& S, const int tid) {
    const int wid = __builtin_amdgcn_readfirstlane(tid >> 6), lane = tid & 63, r32 = lane & 31, hi = lane >> 5;
    constexpr int W = 1 << 30;
    const int NT = (cur.P0 + QB - 1) / KVBLK + 1;
    const int qlo = cur.P0 + wid * QBLK, qm = qlo + r32 - 4 * hi;
    char* V_lds = lds; char* K_lds = lds + 2 * SHM_V;
    float* ws = (float*)(lds + 2 * SHM_V + 2 * SHM_K) + wid * 64; float* li_l = ws, * al_l = ws + 32;
    float m_reg = -1e30f, l_reg = 0; f32x16 o[4] = {};
    const int sr = tid >> 4, sc = (tid & 15) * 8, vst0 = v_st(sr, sc), vst1 = v_st(32 + sr, sc), kws = KSWZ(sr, sc * 2);
    const unsigned voff = (unsigned)(sr * LD + sc) * 2u, qoff = (unsigned)(r32 * LD + hi * 8) * 2u;
    const int vb0 = (int)(uintptr_t)V_lds + v_rd_base(lane);
    const bf16_t* Kh = cur.K; const bf16_t* Vh = cur.V;
    unsigned* rm_l = (unsigned*)(lds + LDS_BYTES) + wid * 64;
    if constexpr (MOBA) { const unsigned long long rmask = cur.RM[(size_t)(wid * QBLK + r32) * 8]; if (hi == 0) { rm_l[2 * r32] = (unsigned)rmask; rm_l[2 * r32 + 1] = (unsigned)(rmask >> 32); } }
#define RESC(a) do { if (__any((a) < 1.f)) { if (hi == 0) al_l[r32] = (a); asm volatile("s_waitcnt lgkmcnt(0)" ::: "memory");              \
                     for (int d_ = 0; d_ < 4; ++d_) for (int r = 0; r < 16; ++r) o[d_][r] *= al_l[crow(r, hi)]; } } while (0)
#define KBASE(t) ((t) * KVBLK)
#define MASKT(P0_, P1_, t) do { const int kb_ = KBASE(t); if (kb_ + KVBLK - 1 > qlo || kb_ <= qlo + QBLK - 1 - W) mask_tile(P0_, P1_, qm - kb_, (unsigned)W); \
                                if constexpr (MOBA) { const int blk_ = kb_ >> 8; const unsigned mw_ = rm_l[2 * r32 + (blk_ >> 5)]; mask_all(P0_, P1_, ((mw_ >> (blk_ & 31)) & 1u) == 0u); } } while (0)
    constexpr int NQL = 8;
#define SEAM_K0() do { VMWN(NQL); SWRITE_HK(0); SBAR(); } while (0)
    f32x16 pA0, pA1, pB0, pB1; float mnA, mnB, alA, alB; bf16x8 pa0, pa1, pa2, pa3;
    SWRITE_HV(0); SBAR();
    if (NT > 1) { SLOAD_H(Kh, Vh, KBASE(1)); }
    SBAR(); qkt<0>(pA0, pA1, K_lds, r32, hi, S.qr);
    MASKT(pA0, pA1, 0); partialSM(pA0, pA1, m_reg, mnA, alA);
    if (NT > 1) { VMW(); SWRITE_H(1); }
    __syncthreads();
#define HALF_STEP(PX0, PX1, mnX, alX, PY0, PY1, alY, t, KB, VB, SB) do {                                                      \
        SBAR(); qkt<KB>(PX0, PX1, K_lds, r32, hi, S.qr);                                             \
        finishSM(PY0, PY1, alY, l_reg, pa0, pa1, pa2, pa3); SBAR();                                                           \
        if ((t) + 1 < NT) { SLOAD_H(Kh, Vh, KBASE((t) + 1)); SBAR(); }                                               \
        pv_tile<VB>(o, vb0, pa0, pa1, pa2, pa3); MASKT(PX0, PX1, (t)); partialSM(PX0, PX1, m_reg, mnX, alX);                                        \
        __syncthreads();                                                                                                      \
        if ((t) + 1 < NT) { VMW(); SWRITE_H(SB); }                                                                          \
        RESC(alX); __syncthreads(); } while (0)
    for (int t = 1; t + 1 < NT; t += 2) {
        HALF_STEP(pB0, pB1, mnB, alB, pA0, pA1, alA, t, 1, 0, 0);
        HALF_STEP(pA0, pA1, mnA, alA, pB0, pB1, alB, t + 1, 0, 1, 1);
    }
    const bool even = (NT & 1) == 0;
    if (even) { SBAR(); qkt<1>(pB0, pB1, K_lds, r32, hi, S.qr); SBAR(); }
    SLOAD_H(nxt.K, nxt.V, 0); SBAR();
    { const char* qb_ = (const char*)nxt.Q + (size_t)(wid * QBLK) * (LD * 2);
#pragma unroll
      for (int d0 = 0; d0 < 8; ++d0) S.qr[d0] = *(const bf16x8*)(qb_ + qoff + d0 * 32); }
    SBAR();
    finishSM(pA0, pA1, alA, l_reg, pa0, pa1, pa2, pa3); SBAR();
    pv_tile<0>(o, vb0, pa0, pa1, pa2, pa3);
    if (even) { MASKT(pB0, pB1, NT - 1); partialSM(pB0, pB1, m_reg, mnB, alB); __syncthreads(); RESC(alB);
        finishSM(pB0, pB1, alB, l_reg, pa0, pa1, pa2, pa3); SBAR(); pv_tile<1>(o, vb0, pa0, pa1, pa2, pa3); }
    SBAR(); SEAM_K0();
    if (hi == 0) li_l[r32] = l_reg; asm volatile("s_waitcnt lgkmcnt(0)" ::: "memory");
    float rli[16];
#pragma unroll
    for (int r = 0; r < 16; ++r) rli[r] = __builtin_amdgcn_rcpf(li_l[crow(r, hi)]);
    const char* ob_ = (const char*)cur.O + (size_t)(wid * QBLK) * (LDO * 2);
    int lane_e; asm volatile("v_mbcnt_lo_u32_b32 %0, -1, 0\n\tv_mbcnt_hi_u32_b32 %0, -1, %0" : "=v"(lane_e));
    const int r32e = lane_e & 31, hie = lane_e >> 5;
    const unsigned ooff = (unsigned)(4 * hie * LDO + r32e) * 2u;
#pragma unroll
    for (int r = 0; r < 16; ++r) { const char* orp_ = ob_ + (size_t)((r & 3) + 8 * (r >> 2)) * (LDO * 2);
#pragma unroll
        for (int d0 = 0; d0 < 4; ++d0) { const float v = o[d0][r] * rli[r];
            const float vn = xl_xor(v, lane_e, 1);
            if ((r32e & 1) == 0) *(unsigned*)(orp_ + d0 * 64 + ooff) = cvtpk(v, vn); } }
    __syncthreads();
#undef RESC
#undef KBASE
#undef MASKT
#undef SEAM_K0
#undef HALF_STEP
}

struct SparseRef { const bf16_t* Qb; const bf16_t* K; const bf16_t* V; const unsigned* list; int q0; int nrows; unsigned dbase; int causal; };
constexpr unsigned SP_TRASH = 32768u * 8u * 4u;
constexpr int SP_TAB = LDS_BYTES;
__device__ __forceinline__ void sp_entry(const SparseRef& R, int ridx, unsigned& qrow, unsigned& dest) {
    unsigned e; bool valid = true;
    if (R.list) { valid = ridx < R.nrows; e = R.list[valid ? ridx : 0]; } else e = (unsigned)(R.q0 + ridx) | (3u << 14);
    qrow = e & 16383u; dest = valid ? R.dbase + qrow * 32u + (e >> 14) : SP_TRASH;
}
template <int LD>
__device__ __forceinline__ void sparse_prime(const SparseRef& cur, char* lds, Seam& S, const int tid) {
    const int wid = __builtin_amdgcn_readfirstlane(tid >> 6), lane = tid & 63, r32 = lane & 31, hi = lane >> 5;
    const int sr = tid >> 4, sc = (tid & 15) * 8, kws = KSWZ(sr, sc * 2); char* K_lds = lds + 2 * SHM_V;
    const unsigned voff = (unsigned)(sr * LD + sc) * 2u;
    unsigned* tab = (unsigned*)(lds + SP_TAB) + wid * 128;
    unsigned qrow, dest; sp_entry(cur, wid * QBLK + r32, qrow, dest);
    if (hi == 0) tab[32 + r32] = dest;
    { const char* qb_ = (const char*)cur.Qb; const unsigned qoff = (qrow * (unsigned)LD + (unsigned)hi * 8u) * 2u;
      for (int d0 = 0; d0 < 8; ++d0) S.qr[d0] = *(const bf16x8*)(qb_ + qoff + d0 * 32); }
    SLOAD_H(cur.K, cur.V, 0); VMW(); SWRITE_HK(0);
    __syncthreads();
}
template <int LD>
__device__ __forceinline__ void sparse_block(const SparseRef& cur, const SparseRef& nxt, bf16_t* PART, float* ML, char* lds, Seam& S, const int tid) {
    const int wid = __builtin_amdgcn_readfirstlane(tid >> 6), lane = tid & 63, r32 = lane & 31, hi = lane >> 5;
    constexpr int W = 1 << 30; constexpr int NT = 4;
    const int qlo = wid * QBLK, qm = qlo + r32 - 4 * hi;
    char* V_lds = lds; char* K_lds = lds + 2 * SHM_V;
    float* ws = (float*)(lds + 2 * SHM_V + 2 * SHM_K) + wid * 64; float* li_l = ws, * al_l = ws + 32;
    unsigned* tab = (unsigned*)(lds + SP_TAB) + wid * 128;
    float m_reg = -1e30f, l_reg = 0; f32x16 o[4] = {};
    const int sr = tid >> 4, sc = (tid & 15) * 8, vst0 = v_st(sr, sc), vst1 = v_st(32 + sr, sc), kws = KSWZ(sr, sc * 2);
    const unsigned voff = (unsigned)(sr * LD + sc) * 2u;
    const int vb0 = (int)(uintptr_t)V_lds + v_rd_base(lane);
    const bf16_t* Kh = cur.K; const bf16_t* Vh = cur.V;
    const bool causal = cur.causal != 0;
    if (hi == 0) tab[64 + r32] = tab[32 + r32];
#define RESC(a) do { if (__any((a) < 1.f)) { if (hi == 0) al_l[r32] = (a); asm volatile("s_waitcnt lgkmcnt(0)" ::: "memory");              \
                     for (int d_ = 0; d_ < 4; ++d_) for (int r = 0; r < 16; ++r) o[d_][r] *= al_l[crow(r, hi)]; } } while (0)
#define KBASE(t) ((t) * KVBLK)
#define MASKT(P0_, P1_, t) do { const int kb_ = KBASE(t); if (causal && (kb_ + KVBLK - 1 > qlo)) mask_tile(P0_, P1_, qm - kb_, (unsigned)W); } while (0)
    constexpr int NQL = 8;
#define SEAM_K0() do { VMWN(NQL); SWRITE_HK(0); SBAR(); } while (0)
    f32x16 pA0, pA1, pB0, pB1; float mnA, mnB, alA, alB; bf16x8 pa0, pa1, pa2, pa3;
    SWRITE_HV(0); SBAR();
    SLOAD_H(Kh, Vh, KBASE(1));
    unsigned nq_, nd_; sp_entry(nxt, wid * QBLK + r32, nq_, nd_);
    SBAR(); qkt<0>(pA0, pA1, K_lds, r32, hi, S.qr);
    MASKT(pA0, pA1, 0); partialSM(pA0, pA1, m_reg, mnA, alA);
    VMW(); SWRITE_H(1);
    if (hi == 0) { tab[r32] = nq_; tab[32 + r32] = nd_; }
    __syncthreads();
#define HALF_STEP(PX0, PX1, mnX, alX, PY0, PY1, alY, t, KB, VB, SB) do {                                                      \
        SBAR(); qkt<KB>(PX0, PX1, K_lds, r32, hi, S.qr);                                             \
        finishSM(PY0, PY1, alY, l_reg, pa0, pa1, pa2, pa3); SBAR();                                                           \
        if ((t) + 1 < NT) { SLOAD_H(Kh, Vh, KBASE((t) + 1)); SBAR(); }                                               \
        pv_tile<VB>(o, vb0, pa0, pa1, pa2, pa3); MASKT(PX0, PX1, (t)); partialSM(PX0, PX1, m_reg, mnX, alX);                                        \
        __syncthreads();                                                                                                      \
        if ((t) + 1 < NT) { VMW(); SWRITE_H(SB); }                                                                          \
        RESC(alX); __syncthreads(); } while (0)
    HALF_STEP(pB0, pB1, mnB, alB, pA0, pA1, alA, 1, 1, 0, 0);
    HALF_STEP(pA0, pA1, mnA, alA, pB0, pB1, alB, 2, 0, 1, 1);
    SBAR(); qkt<1>(pB0, pB1, K_lds, r32, hi, S.qr); SBAR();
    SLOAD_H(nxt.K, nxt.V, 0); SBAR();
    { const char* qb_ = (const char*)nxt.Qb; const unsigned qoff = (tab[r32] * (unsigned)LD + (unsigned)hi * 8u) * 2u;
#pragma unroll
      for (int d0 = 0; d0 < 8; ++d0) S.qr[d0] = *(const bf16x8*)(qb_ + qoff + d0 * 32); }
    SBAR();
    finishSM(pA0, pA1, alA, l_reg, pa0, pa1, pa2, pa3); SBAR();
    pv_tile<0>(o, vb0, pa0, pa1, pa2, pa3);
    MASKT(pB0, pB1, NT - 1); partialSM(pB0, pB1, m_reg, mnB, alB); __syncthreads(); RESC(alB);
    finishSM(pB0, pB1, alB, l_reg, pa0, pa1, pa2, pa3); SBAR(); pv_tile<1>(o, vb0, pa0, pa1, pa2, pa3);
    SBAR(); SEAM_K0();
    if (hi == 0) li_l[r32] = l_reg; asm volatile("s_waitcnt lgkmcnt(0)" ::: "memory");
    float rli[16];
#pragma unroll
    for (int r = 0; r < 16; ++r) rli[r] = __builtin_amdgcn_rcpf(li_l[crow(r, hi)]);
    int lane_e; asm volatile("v_mbcnt_lo_u32_b32 %0, -1, 0\n\tv_mbcnt_hi_u32_b32 %0, -1, %0" : "=v"(lane_e));
    const int r32e = lane_e & 31, hie = lane_e >> 5;
    if (hie == 0) { const unsigned dst = tab[64 + r32e]; typedef float f32x2_t __attribute__((ext_vector_type(2))); *(f32x2_t*)(ML + (size_t)dst * 2) = (f32x2_t){m_reg, l_reg}; }
    const char* pb_ = (const char*)PART;
#pragma unroll
    for (int r = 0; r < 16; ++r) { const unsigned rowoff = tab[64 + crow(r, hie)] * 256u + (unsigned)r32e * 2u;
#pragma unroll
        for (int d0 = 0; d0 < 4; ++d0) { const float v = o[d0][r] * rli[r];
            const float vn = xl_xor(v, lane_e, 1);
            if ((r32e & 1) == 0) *(unsigned*)(pb_ + rowoff + d0 * 64) = cvtpk(v, vn); } }
    __syncthreads();
#undef RESC
#undef KBASE
#undef MASKT
#undef SEAM_K0
#undef HALF_STEP
}
#undef ROW

constexpr int SHM_V2 = KVBLK * 256 * 2, LDS2_K = 2 * SHM_V2, LDS2_WS = LDS2_K + 2 * SHM_K, LDS2_BYTES = LDS2_WS + NW * 64 * 4;
struct Block2Ref { const bf16_t* Q; const bf16_t* K; const bf16_t* V; bf16_t* O; int P0; };
template <int VB>
__device__ __forceinline__ void pv_tile2(f32x16* o, int vb0, bf16x8 pa0, bf16x8 pa1, bf16x8 pa2, bf16x8 pa3) {
#define TRRD(dst, off) asm volatile("ds_read_b64_tr_b16 %0, %1 offset:%2" : "=&v"(dst) : "v"(vb0), "i"(off) : "memory")
#define LDA(d0) do { constexpr int b_ = VB * SHM_V2 + (d0) * 512; TRRD(l0, b_); TRRD(h0, b_ + 4096); TRRD(l1, b_ + 8192); TRRD(h1, b_ + 12288); } while (0)
#define LDB(d0) do { constexpr int b_ = VB * SHM_V2 + (d0) * 512; TRRD(l2, b_ + 16384); TRRD(h2, b_ + 20480); TRRD(l3, b_ + 24576); TRRD(h3, b_ + 28672); } while (0)
#define MMA01(d0) do { \
        o[d0] = __builtin_amdgcn_mfma_f32_32x32x16_bf16(pa0, (bf16x8){l0[0], l0[1], l0[2], l0[3], h0[0], h0[1], h0[2], h0[3]}, o[d0], 0, 0, 0);   \
        o[d0] = __builtin_amdgcn_mfma_f32_32x32x16_bf16(pa1, (bf16x8){l1[0], l1[1], l1[2], l1[3], h1[0], h1[1], h1[2], h1[3]}, o[d0], 0, 0, 0); } while (0)
#define MMA23(d0) do { \
        o[d0] = __builtin_amdgcn_mfma_f32_32x32x16_bf16(pa2, (bf16x8){l2[0], l2[1], l2[2], l2[3], h2[0], h2[1], h2[2], h2[3]}, o[d0], 0, 0, 0);   \
        o[d0] = __builtin_amdgcn_mfma_f32_32x32x16_bf16(pa3, (bf16x8){l3[0], l3[1], l3[2], l3[3], h3[0], h3[1], h3[2], h3[3]}, o[d0], 0, 0, 0); } while (0)
#define W4() do { asm volatile("s_waitcnt lgkmcnt(4)" ::: "memory"); SBAR(); } while (0)
#define W0() do { asm volatile("s_waitcnt lgkmcnt(0)" ::: "memory"); SBAR(); } while (0)
    s16x4 l0, l1, l2, l3, h0, h1, h2, h3;
    LDA(0);
#define STEP(d0) do { LDB(d0); W4(); MMA01(d0); SBAR(); LDA((d0) + 1); W4(); MMA23(d0); SBAR(); } while (0)
    STEP(0); STEP(1); STEP(2); STEP(3); STEP(4); STEP(5); STEP(6);
    LDB(7); W4(); MMA01(7); SBAR(); W0(); MMA23(7);
#undef STEP
#undef W0
#undef W4
#undef MMA23
#undef MMA01
#undef LDB
#undef LDA
#undef TRRD
}
template <int LD, int LDO>
__device__ __forceinline__ void causal_block2(const Block2Ref& cur, char* lds, const int tid) {
    const int wid = __builtin_amdgcn_readfirstlane(tid >> 6), lane = tid & 63, r32 = lane & 31, hi = lane >> 5;
    constexpr int W = 1 << 30;
    const int NT = (cur.P0 + QB - 1) / KVBLK + 1;
    const int qlo = cur.P0 + wid * QBLK, qm = qlo + r32 - 4 * hi;
    char* V_lds = lds; char* K_lds = lds + LDS2_K;
    float* ws = (float*)(lds + LDS2_WS) + wid * 64; float* li_l = ws, * al_l = ws + 32;
    float m_reg = -1e30f, l_reg = 0; f32x16 o[8] = {};
    const unsigned qoff = (unsigned)(r32 * LD + hi * 8) * 2u;
    const int vb0 = (int)(uintptr_t)V_lds + v_rd_base(lane);
    unsigned vofk[2], vofv;
#pragma unroll
    for (int j = 0; j < 2; ++j) { const int row = wid * 8 + j * 4 + (lane >> 4); vofk[j] = (unsigned)(row * LD) * 2u + (unsigned)(((lane & 15) ^ (row & 7)) * 16); }
    { const int kk = wid * 8 + ((lane & 31) >> 2), k = (kk & ~0xC) | ((kk & 4) << 1) | ((kk & 8) >> 1); vofv = (unsigned)(k * LD + (lane >> 5) * 32 + (lane & 3) * 8) * 2u; }
    typedef __attribute__((address_space(3))) unsigned las_u32;
    const unsigned ldsK = (unsigned)(uintptr_t)K_lds + (unsigned)wid * 2048u, ldsV = (unsigned)(uintptr_t)V_lds + (unsigned)wid * 4096u;
    bf16x8 qr[8];
    { const char* qb_ = (const char*)cur.Q + (size_t)(wid * QBLK) * (LD * 2);
#pragma unroll
      for (int d0 = 0; d0 < 8; ++d0) qr[d0] = *(const bf16x8*)(qb_ + qoff + d0 * 32); }
#define DMA2(k0, bf) do { const char* kt_ = (const char*)cur.K + (size_t)(k0) * (LD * 2); const char* vt_ = (const char*)cur.V + (size_t)(k0) * (LD * 2);              \
        _Pragma("unroll") for (int j = 0; j < 2; ++j) __builtin_amdgcn_global_load_lds((const unsigned*)(kt_ + vofk[j]), (las_u32*)(uintptr_t)(ldsK + (bf) * SHM_K + j * 1024), 16, 0, 0);              \
        _Pragma("unroll") for (int j = 0; j < 4; ++j) __builtin_amdgcn_global_load_lds((const unsigned*)(vt_ + j * 128 + vofv), (las_u32*)(uintptr_t)(ldsV + (bf) * SHM_V2 + j * 1024), 16, 0, 0); } while (0)
#define RESC2(a) do { if (__any((a) < 1.f)) { if (hi == 0) al_l[r32] = (a); asm volatile("s_waitcnt lgkmcnt(0)" ::: "memory");              \
                     for (int d_ = 0; d_ < 8; ++d_) for (int r = 0; r < 16; ++r) o[d_][r] *= al_l[crow(r, hi)]; } } while (0)
    DMA2(0, 0); VMW();
    __syncthreads();
    f32x16 p0, p1; float mn, al; bf16x8 pa0, pa1, pa2, pa3;
#define TILE2(t, BUF) do { const int kb_ = (t) * KVBLK;                                                                        \
        if ((t) + 1 < NT) { DMA2(kb_ + KVBLK, 1 - (BUF)); SBAR(); }              \
        qkt<BUF>(p0, p1, K_lds, r32, hi, qr); SBAR();                                                                          \
        if (kb_ + KVBLK - 1 > qlo) mask_tile(p0, p1, qm - kb_, (unsigned)W);                                                   \
        partialSM(p0, p1, m_reg, mn, al); finishSM(p0, p1, al, l_reg, pa0, pa1, pa2, pa3); SBAR();                             \
        RESC2(al); SBAR();                                                                                                     \
        pv_tile2<BUF>(o, vb0, pa0, pa1, pa2, pa3);                                                                             \
        VMW(); __syncthreads(); } while (0)
    for (int t = 0; t < NT; t += 2) { TILE2(t, 0); TILE2(t + 1, 1); }
#undef TILE2
    if (hi == 0) li_l[r32] = l_reg; asm volatile("s_waitcnt lgkmcnt(0)" ::: "memory");
    float rli[16];
#pragma unroll
    for (int r = 0; r < 16; ++r) rli[r] = __builtin_amdgcn_rcpf(li_l[crow(r, hi)]);
    const char* ob_ = (const char*)cur.O + (size_t)(wid * QBLK) * (LDO * 2);
    int lane_e; asm volatile("v_mbcnt_lo_u32_b32 %0, -1, 0\n\tv_mbcnt_hi_u32_b32 %0, -1, %0" : "=v"(lane_e));
    const int r32e = lane_e & 31, hie = lane_e >> 5;
    const unsigned ooff = (unsigned)(4 * hie * LDO + r32e) * 2u;
#pragma unroll
    for (int r = 0; r < 16; ++r) { const char* orp_ = ob_ + (size_t)((r & 3) + 8 * (r >> 2)) * (LDO * 2);
#pragma unroll
        for (int d0 = 0; d0 < 8; ++d0) { const float v = o[d0][r] * rli[r];
            const float vn = xl_xor(v, lane_e, 1);
            if ((r32e & 1) == 0) *(unsigned*)(orp_ + d0 * 64 + ooff) = cvtpk(v, vn); } }
    __syncthreads();
#undef DMA2
#undef RESC2
}

constexpr int SP2_WS = 131072 + 10240;
template <int LD>
__device__ __forceinline__ void sparse2_stage(const bf16_t* Kblk, const bf16_t* Vblk, char* lds, const int tid) {
    const int wid = __builtin_amdgcn_readfirstlane(tid >> 6), lane = tid & 63;
    typedef __attribute__((address_space(3))) unsigned las_u32;
    unsigned vofk[2], vofv;
#pragma unroll
    for (int j = 0; j < 2; ++j) { const int row = wid * 8 + j * 4 + (lane >> 4); vofk[j] = (unsigned)(row * LD) * 2u + (unsigned)(((lane & 15) ^ (row & 7)) * 16); }
    { const int kk = wid * 8 + ((lane & 31) >> 2), k = (kk & ~0xC) | ((kk & 4) << 1) | ((kk & 8) >> 1); vofv = (unsigned)(k * LD + (lane >> 5) * 32 + (lane & 3) * 8) * 2u; }
    const unsigned ldsK = (unsigned)(uintptr_t)lds + (unsigned)wid * 2048u, ldsV = (unsigned)(uintptr_t)lds + 65536u + (unsigned)wid * 2048u;
#pragma unroll
    for (int T = 0; T < 4; ++T) { const char* kt_ = (const char*)Kblk + (size_t)(T * KVBLK) * (LD * 2); const char* vt_ = (const char*)Vblk + (size_t)(T * KVBLK) * (LD * 2);
#pragma unroll
        for (int j = 0; j < 2; ++j) { __builtin_amdgcn_global_load_lds((const unsigned*)(kt_ + vofk[j]), (las_u32*)(uintptr_t)(ldsK + T * SHM_K + j * 1024), 16, 0, 0);
                                      __builtin_amdgcn_global_load_lds((const unsigned*)(vt_ + j * 128 + vofv), (las_u32*)(uintptr_t)(ldsV + T * SHM_V + j * 1024), 16, 0, 0); } }
    asm volatile("s_waitcnt vmcnt(0)" ::: "memory");
}
__device__ __forceinline__ void sparse2_prime(const SparseRef& R, char* lds, const int tid, bf16x8 (&qr)[8], int LD) {
    const int wid = __builtin_amdgcn_readfirstlane(tid >> 6), lane = tid & 63, r32 = lane & 31, hi = lane >> 5;
    float* ws = (float*)(lds + SP2_WS) + wid * 128; unsigned* dst_l = (unsigned*)(ws + 64);
    unsigned qrow, dest; sp_entry(R, wid * QBLK + r32, qrow, dest);
    if (hi == 0) dst_l[r32] = dest;
    const char* qb_ = (const char*)R.Qb; const unsigned qoff = (qrow * (unsigned)LD + (unsigned)hi * 8u) * 2u;
#pragma unroll
    for (int d0 = 0; d0 < 8; ++d0) qr[d0] = *(const bf16x8*)(qb_ + qoff + d0 * 32);
}
template <int LD>
__device__ __forceinline__ void sparse2_wave(const SparseRef& R, const SparseRef& Rn, const bool has_next, const int bank, bf16_t* PART, float* ML, char* lds, const int tid, bf16x8 (&qr)[8]) {
    const int wid = __builtin_amdgcn_readfirstlane(tid >> 6), lane = tid & 63, r32 = lane & 31, hi = lane >> 5;
    constexpr int W = 1 << 30;
    const int qlo = wid * QBLK, qm = qlo + r32 - 4 * hi;
    char* K_lds = lds; char* V_lds = lds + 65536;
    float* ws = (float*)(lds + SP2_WS) + wid * 128; float* li_l = ws, * al_l = ws + 32; unsigned* dst_l = (unsigned*)(ws + 64) + bank * 32; unsigned* ndst_l = (unsigned*)(ws + 64) + (bank ^ 1) * 32;
    const int vb0 = (int)(uintptr_t)V_lds + v_rd_base(lane);
    unsigned nq_ = 0, nd_ = SP_TRASH; if (has_next) sp_entry(Rn, wid * QBLK + r32, nq_, nd_);
    float m_reg = -1e30f, l_reg = 0; f32x16 o[4] = {};
    const bool causal = R.causal != 0;
    f32x16 p0, p1; float mn, al; bf16x8 pa0, pa1, pa2, pa3; bf16x8 qn[8];
#define RESC3(a) do { if (__any((a) < 1.f)) { if (hi == 0) al_l[r32] = (a); asm volatile("s_waitcnt lgkmcnt(0)" ::: "memory");              \
                     for (int d_ = 0; d_ < 4; ++d_) for (int r = 0; r < 16; ++r) o[d_][r] *= al_l[crow(r, hi)]; } } while (0)
#define TILE3(T) do { qkt<T>(p0, p1, K_lds, r32, hi, qr); SBAR();                                                              \
        if (causal && ((T) * KVBLK + KVBLK - 1 > qlo)) mask_tile(p0, p1, qm - (T) * KVBLK, (unsigned)W);                       \
        partialSM(p0, p1, m_reg, mn, al); finishSM(p0, p1, al, l_reg, pa0, pa1, pa2, pa3); SBAR(); RESC3(al); SBAR();          \
        pv_tile<T>(o, vb0, pa0, pa1, pa2, pa3); SBAR(); } while (0)
    TILE3(0); TILE3(1);
    if (has_next) { if (hi == 0) ndst_l[r32] = nd_;
        const char* qb_ = (const char*)Rn.Qb; const unsigned qoff = (nq_ * (unsigned)LD + (unsigned)hi * 8u) * 2u;
#pragma unroll
        for (int d0 = 0; d0 < 8; ++d0) qn[d0] = *(const bf16x8*)(qb_ + qoff + d0 * 32); SBAR(); }
    TILE3(2); TILE3(3);
#undef TILE3
#undef RESC3
    if (hi == 0) li_l[r32] = l_reg; asm volatile("s_waitcnt lgkmcnt(0)" ::: "memory");
    float rli[16];
#pragma unroll
    for (int r = 0; r < 16; ++r) rli[r] = __builtin_amdgcn_rcpf(li_l[crow(r, hi)]);
    int lane_e; asm volatile("v_mbcnt_lo_u32_b32 %0, -1, 0\n\tv_mbcnt_hi_u32_b32 %0, -1, %0" : "=v"(lane_e));
    const int r32e = lane_e & 31, hie = lane_e >> 5;
    if (hie == 0) { const unsigned dst = dst_l[r32e]; typedef float f32x2_t __attribute__((ext_vector_type(2))); *(f32x2_t*)(ML + (size_t)dst * 2) = (f32x2_t){m_reg, l_reg}; }
    const char* pb_ = (const char*)PART;
#pragma unroll
    for (int r = 0; r < 16; ++r) { const unsigned rowoff = dst_l[crow(r, hie)] * 256u + (unsigned)r32e * 2u;
#pragma unroll
        for (int d0 = 0; d0 < 4; ++d0) { const float v = o[d0][r] * rli[r];
            const float vn = xl_xor(v, lane_e, 1);
            if ((r32e & 1) == 0) *(unsigned*)(pb_ + rowoff + d0 * 64) = cvtpk(v, vn); } }
    asm volatile("s_waitcnt lgkmcnt(0)" ::: "memory");
    if (has_next) {
#pragma unroll
        for (int d0 = 0; d0 < 8; ++d0) qr[d0] = qn[d0]; }
}

__device__ __forceinline__ void gate_stage_kmean(const float* km_bh, char* lds, const int tid) {
    const int row = tid >> 3, c0 = (tid & 7) * 2;
#pragma unroll
    for (int c = c0; c < c0 + 2; ++c) { const f32x4 a = *(const f32x4*)(km_bh + row * 128 + c * 8), b = *(const f32x4*)(km_bh + row * 128 + c * 8 + 4);
        u32x4 w = {cvtpk(a[0], a[1]), cvtpk(a[2], a[3]), cvtpk(b[0], b[1]), cvtpk(b[2], b[3])};
        *(u32x4*)(lds + KSWZ(row, c * 16)) = w; }
}
template <int LD>
__device__ __forceinline__ void gate_top3(const bf16_t* Qblk, int nblk, char* lds, const int tid, int& k0, int& k1, int& k2) {
    const int wid = __builtin_amdgcn_readfirstlane(tid >> 6), lane = tid & 63, r32 = lane & 31, hi = lane >> 5;
    bf16x8 qr[8];
    { const char* qb_ = (const char*)Qblk + (size_t)(wid * QBLK) * (LD * 2); const unsigned qoff = (unsigned)(r32 * LD + hi * 8) * 2u;
#pragma unroll
      for (int d0 = 0; d0 < 8; ++d0) qr[d0] = *(const bf16x8*)(qb_ + qoff + d0 * 32); }
    f32x16 p0, p1; qkt<0>(p0, p1, lds, r32, hi, qr);
    const float NEG = -__builtin_inff();
#pragma unroll
    for (int r = 0; r < 16; ++r) { const int bi_ = (r & 3) + 8 * (r >> 2) + 4 * hi; if (bi_ >= nblk) p0[r] = NEG; if (bi_ + 32 >= nblk) p1[r] = NEG; }
    int pick[3];
#pragma unroll
    for (int t = 0; t < 3; ++t) {
        float bv = NEG; int bidx = 64;
#pragma unroll
        for (int r = 0; r < 16; ++r) { const int bi_ = (r & 3) + 8 * (r >> 2) + 4 * hi; if (p0[r] > bv) { bv = p0[r]; bidx = bi_; } }
#pragma unroll
        for (int r = 0; r < 16; ++r) { const int bi_ = 32 + (r & 3) + 8 * (r >> 2) + 4 * hi; if (p1[r] > bv) { bv = p1[r]; bidx = bi_; } }
        auto rv = __builtin_amdgcn_permlane32_swap(__float_as_uint(bv), __float_as_uint(bv), false, false);
        auto ri = __builtin_amdgcn_permlane32_swap((unsigned)bidx, (unsigned)bidx, false, false);
        const float va = __uint_as_float(rv[0]), vb = __uint_as_float(rv[1]); const int ia = (int)ri[0], ib = (int)ri[1];
        const bool takea = (va > vb) || (va == vb && ia < ib);
        const float wv = takea ? va : vb; const int wi = (wv > NEG) ? (takea ? ia : ib) : 64;
        pick[t] = wi;
#pragma unroll
        for (int r = 0; r < 16; ++r) { const int bi_ = (r & 3) + 8 * (r >> 2) + 4 * hi; if (bi_ == wi) p0[r] = NEG; if (bi_ + 32 == wi) p1[r] = NEG; }
    }
    k0 = pick[0]; k1 = pick[1]; k2 = pick[2];
}
#undef VMW
#undef VMWN
#undef SLOAD_H
#undef SWRITE_HK
#undef SWRITE_HV
#undef SWRITE_H
#undef KSWZ
#undef SBAR
}
#define GAS __attribute__((address_space(1)))
#define LAS __attribute__((address_space(3)))
typedef unsigned short bf16;
typedef unsigned v4u __attribute__((ext_vector_type(4)));
typedef float f32x4 __attribute__((ext_vector_type(4)));
typedef short bf16x8 __attribute__((ext_vector_type(8)));
typedef GAS unsigned gu32;
typedef GAS unsigned long long gu64;
#define RLX_AGENT __ATOMIC_RELAXED, __HIP_MEMORY_SCOPE_AGENT
#define LDS_WAIT() asm volatile("s_waitcnt lgkmcnt(0)" ::: "memory")
#define VM_WAIT() asm volatile("s_waitcnt vmcnt(0)" ::: "memory")
__device__ __forceinline__ unsigned long long rt() { return __builtin_amdgcn_s_memrealtime(); }
__device__ __forceinline__ unsigned f2bf(float f) { unsigned u = __builtin_bit_cast(unsigned, f); return (u + 0x7fffu + ((u >> 16) & 1u)) >> 16; }
__device__ __forceinline__ unsigned pk2(float lo, float hi) { return f2bf(lo) | (f2bf(hi) << 16); }
#define XB_TMO      128
#define XB_XCNT(j)  (256  + 64 * (j))
#define XB_XSUB(j)  (1280 + 64 * (j))
#define XB_XGEN(j)  (2304 + 64 * (j))
#define XB_TOP      3328
#define XB_TOPGEN   3392
#define XCD_BAR_WORDS 3456
#define XB_SPIN_CAP (1u << 18)

__device__ __forceinline__ unsigned xb_ld(unsigned* p)              { return __hip_atomic_load(p, __ATOMIC_RELAXED, __HIP_MEMORY_SCOPE_AGENT); }
__device__ __forceinline__ unsigned xb_add(unsigned* p, unsigned v) { return __hip_atomic_fetch_add(p, v, __ATOMIC_RELAXED, __HIP_MEMORY_SCOPE_AGENT); }
__device__ __forceinline__ unsigned xb_xcc_id() { return (unsigned)__builtin_amdgcn_s_getreg((3 << 11) | 20) & 0xFu; }
#define XB_SPIN(cond, bar) do { unsigned _sp = 0; while (cond) { __builtin_amdgcn_s_sleep(1); \
    if ((++_sp & 255u) == 0u) { if (xb_ld(&(bar)[XB_TMO])) break; if (_sp > XB_SPIN_CAP) { atomicAdd(&(bar)[XB_TMO], 1u); break; } } } } while (0)

struct XcdBarrier {
    unsigned* bar; unsigned x; unsigned G;
    volatile LAS unsigned* st;
};

__device__ __forceinline__ XcdBarrier xcd_barrier_post(unsigned* bar, volatile LAS unsigned* st, const bool leader) {
    XcdBarrier b; b.bar = bar; b.x = xb_xcc_id(); b.st = st; b.G = gridDim.x * gridDim.y * gridDim.z;
    if (leader) (void)xb_add(&bar[XB_XCNT(b.x)], 1u);
    return b;
}
__device__ __forceinline__ void xcd_barrier_complete(unsigned* bar, unsigned x, unsigned G, unsigned& nloc, unsigned& nx) {
    unsigned sum, cnt, mine, sp = 0u;
    for (;;) {
        sum = 0u; cnt = 0u; mine = 0u;
#pragma unroll
        for (unsigned j = 0; j < 16; ++j) { const unsigned c = xb_ld(&bar[XB_XCNT(j)]); sum += c; cnt += (c > 0u) ? 1u : 0u; mine = (j == x) ? c : mine; }
        if (sum == G) break;
        __builtin_amdgcn_s_sleep(1);
        if ((++sp & 255u) == 0u) { if (xb_ld(&bar[XB_TMO])) break; if (sp > XB_SPIN_CAP) { atomicAdd(&bar[XB_TMO], 1u); break; } }
    }
    nloc = mine > 0u ? mine : 1u; nx = cnt > 0u ? cnt : 1u;
}

__device__ __forceinline__ void xcd_barrier(const XcdBarrier& b, const bool leader) {
    asm volatile("s_waitcnt vmcnt(0)" ::: "memory");
    __syncthreads();
    if (leader) {
        unsigned* bar = b.bar;
        __builtin_amdgcn_s_waitcnt(0);
        unsigned nloc = b.st[0], nx = b.st[1];
        if (nloc == 0u) { xcd_barrier_complete(bar, b.x, b.G, nloc, nx); b.st[0] = nloc; b.st[1] = nx; }
        const unsigned old = xb_add(&bar[XB_XSUB(b.x)], 1u);
        const unsigned gen = old / nloc;
        if (old + 1u == (gen + 1u) * nloc) {
            __builtin_amdgcn_fence(__ATOMIC_RELEASE, "agent");
            asm volatile("s_waitcnt vmcnt(0)" ::: "memory");
            const unsigned og = xb_add(&bar[XB_TOP], 1u);
            const unsigned tg = og / nx;
            if (og + 1u == (tg + 1u) * nx) xb_add(&bar[XB_TOPGEN], 1u);
            else XB_SPIN(xb_ld(&bar[XB_TOPGEN]) == tg, bar);
            __builtin_amdgcn_fence(__ATOMIC_ACQUIRE, "agent");
            xb_add(&bar[XB_XGEN(b.x)], 1u);
            asm volatile("s_waitcnt vmcnt(0)" ::: "memory");
        } else {
            XB_SPIN(xb_ld(&bar[XB_XGEN(b.x)]) == gen, bar);
            __builtin_amdgcn_fence(__ATOMIC_ACQUIRE, "agent");
            asm volatile("s_waitcnt vmcnt(0)" ::: "memory");
        }
    }
    __syncthreads();
}

#ifndef NLAYERS_RUN
#define NLAYERS_RUN 4
#endif
constexpr int NWAVES = 8, NTHR = 512;
constexpr int BATCH = 2, SEQ = 16384, DM = 2048, DEPTH = 4;
constexpr int M = BATCH * SEQ;
constexpr int EV_IN = 6144, OD_IN = 2560, FFH = 5632, FF2 = 11264, NMOD = 12288;
constexpr float RMS_EPS = 1e-6f, SUBLN_EPS = 1e-5f;
#ifndef MK_PER_PHASE
#define MK_PER_PHASE 0
#endif

constexpr size_t MiB = 1u << 20;
constexpr size_t WS_CTL = 0, CTL_ZERO_BYTES = 3 * MiB;
constexpr size_t WS_SS = 1 * MiB;
constexpr size_t WS_MOD = 3 * MiB;
constexpr size_t WS_KM = 4 * MiB;
constexpr size_t WS_BIAS = 5 * MiB;
constexpr size_t WS_ROPE = 6 * MiB;
constexpr size_t WS_W = 18 * MiB;
constexpr size_t W_EVIN = WS_W;
constexpr size_t W_EVOUT = W_EVIN + 48 * MiB;
constexpr size_t W_ODIN = W_EVOUT + 16 * MiB;
constexpr size_t W_ODOUT = W_ODIN + 20 * MiB;
constexpr size_t W_FFIN = W_ODOUT + 16 * MiB;
constexpr size_t W_FFOUT = W_FFIN + 176 * MiB;
constexpr size_t WS_XH = W_FFOUT + 88 * MiB;
constexpr size_t WS_PROJ = WS_XH + 128 * MiB;
constexpr size_t WS_OT = WS_PROJ + 384 * MiB;
constexpr size_t WS_Y = WS_OT + 128 * MiB;
constexpr size_t WS_PART = WS_Y + 128 * MiB;
constexpr size_t WS_ML = WS_PART + 257 * MiB;
constexpr size_t WS_LIST = WS_ML + 9 * MiB;
constexpr size_t WS_SSP = WS_LIST + 64 * MiB;
constexpr size_t WS_END = WS_SSP + 10 * MiB;
constexpr int CW_BAR = 4096;
constexpr int CW_CNT = 16384;

constexpr int RING_OFF = 0, RING_BYTES = 131072;
constexpr int LDSCTL_OFF = RING_BYTES, MISC_OFF = LDSCTL_OFF + 320;
constexpr int LDS_BYTES = 147456;

struct Args {
    const float* x; const float* c; const float* ada_w; const float* ada_b; const float* ab_w_in; const float* ab_w_out; const float* diff_lambda; const float* diff_subln;
    const float* swa_w_in; const float* swa_b_in; const float* swa_w_out; const float* swa_b_out; const float* swa_sinks; const float* ffn_w_in; const float* ffn_w_out; const float* final_norm;
    float* out; unsigned char* ws;
    float invf128[64]; float invf64[32]; float lam_init[4];
    int ph_lo, ph_hi;
};
static_assert(sizeof(Args) % 8 == 0, "no tail padding");

__device__ __forceinline__ float wave_sum(float v) {
    const int l = xl_lane();
#pragma unroll
    for (int o = 1; o < 64; o <<= 1) v += xl_xor(v, l, o);
    return v;
}

__device__ __forceinline__ unsigned pk2h(float lo, float hi) { typedef _Float16 h2 __attribute__((ext_vector_type(2))); h2 v = {(_Float16)lo, (_Float16)hi}; return __builtin_bit_cast(unsigned, v); }
__device__ __forceinline__ void p0_load(const float* W, int N, int item, int lane, f32x4 (&v)[8]) {
    const int nblk = N / 32, kb = item / nblk, nb = item % nblk, k0 = 64 * kb, n0 = 32 * nb;
#pragma unroll
    for (int i = 0; i < 8; ++i) v[i] = *(const GAS f32x4*)(W + (size_t)(k0 + 8 * i + (lane >> 3)) * N + n0 + 4 * (lane & 7));
}
template <int PERM_KIND, bool F16, bool ACC>
__device__ __forceinline__ void p0_finish(const f32x4 (&v)[8], int K, int N, bf16* WT, LAS float* scr, int item, int lane, const float* sh0, f32x4* pb) {
    const int nblk = N / 32, kb = item / nblk, nb = item % nblk, k0 = 64 * kb, n0 = 32 * nb;
#pragma unroll
    for (int i = 0; i < 8; ++i) { LAS float* d = scr + (8 * i + (lane >> 3)) * 33 + 4 * (lane & 7); d[0] = v[i].x; d[1] = v[i].y; d[2] = v[i].z; d[3] = v[i].w; }
    if constexpr (ACC) {
#pragma unroll
        for (int i = 0; i < 8; ++i) { const int k = k0 + 8 * i + (lane >> 3); pb[0] += v[i] * sh0[k]; pb[1] += v[i] * sh0[NMOD + k]; } }
    LDS_WAIT(); asm volatile("" ::: "memory");
    const int c = lane & 7;
#pragma unroll
    for (int j = 0; j < 4; ++j) { const int n = (lane >> 3) + 8 * j; const LAS float* s = scr + (8 * c) * 33 + n;
        v4u o; if constexpr (F16) { o.x = pk2h(s[0 * 33], s[1 * 33]); o.y = pk2h(s[2 * 33], s[3 * 33]); o.z = pk2h(s[4 * 33], s[5 * 33]); o.w = pk2h(s[6 * 33], s[7 * 33]); }
        else { o.x = pk2(s[0 * 33], s[1 * 33]); o.y = pk2(s[2 * 33], s[3 * 33]); o.z = pk2(s[4 * 33], s[5 * 33]); o.w = pk2(s[6 * 33], s[7 * 33]); }
        const int nn = n0 + n;
        const int dst = PERM_KIND == 1 ? pg8::perm_even_in(nn) : PERM_KIND == 2 ? pg8::perm_odd_in(nn) : PERM_KIND == 3 ? pg8::perm_ffn_in(nn) : nn;
        *(GAS v4u*)(WT + (size_t)dst * K + k0 + 8 * c) = o; }
    LDS_WAIT(); asm volatile("" ::: "memory");
}
template <int PERM_KIND, bool F16, bool ACC>
__device__ __forceinline__ void p0_run(const float* W, int K, int N, bf16* WT, LAS float* scr, int lane, int first, int step, int cnt, const float* sh0 = nullptr, f32x4* pb = nullptr) {
    if (cnt <= 0) return;
    f32x4 va[8], vb[8];
    p0_load(W, N, first, lane, va);
    for (int i = 0; i < cnt; i += 2) {
        if (i + 1 < cnt) p0_load(W, N, first + (i + 1) * step, lane, vb);
        p0_finish<PERM_KIND, F16, ACC>(va, K, N, WT, scr, first + i * step, lane, sh0, pb);
        if (i + 1 < cnt) { if (i + 2 < cnt) p0_load(W, N, first + (i + 2) * step, lane, va);
            p0_finish<PERM_KIND, F16, ACC>(vb, K, N, WT, scr, first + (i + 1) * step, lane, sh0, pb); }
    }
}
__device__ __forceinline__ void dsincos(double x, double& s, double& c) {
    const double k = __builtin_rint(x * 0.63661977236758134308);
    double r = __builtin_fma(-k, 1.57079632679489655800e+00, x); r = __builtin_fma(-k, 6.12323399573676603587e-17, r);
    const double z = r * r;
    double ps = -7.6471637318198164759e-13;
    ps = ps * z + 1.6059043836821614599e-10;
    ps = ps * z - 2.5052108385441718775e-08;
    ps = ps * z + 2.7557319223985890653e-06;
    ps = ps * z - 1.9841269841269841270e-04;
    ps = ps * z + 8.3333333333333333333e-03;
    ps = ps * z - 1.6666666666666666667e-01;
    const double sr = r + r * z * ps;
    double pc = 4.7794773323873852974e-14;
    pc = pc * z - 1.1470745597729724714e-11;
    pc = pc * z + 2.0876756987868098979e-09;
    pc = pc * z - 2.7557319223985890653e-07;
    pc = pc * z + 2.4801587301587301587e-05;
    pc = pc * z - 1.3888888888888888889e-03;
    pc = pc * z + 4.1666666666666666667e-02;
    pc = pc * z - 0.5;
    const double cr = 1.0 + z * pc;
    const int q = ((int)k) & 3;
    s = (q == 0) ? sr : (q == 1) ? cr : (q == 2) ? -sr : -cr;
    c = (q == 0) ? cr : (q == 1) ? -sr : (q == 2) ? -cr : sr;
}

__device__ __forceinline__ void first_norm_phase(const float* xin, const float* sc0, bf16* xa, float* ss, int gw, int NGW, int lane) {
    for (int m0 = gw * 2; m0 < M; m0 += NGW * 2) {
        f32x4 v[2][8]; float s[2];
#pragma unroll
        for (int q = 0; q < 2; ++q) { const GAS f32x4* xr = (const GAS f32x4*)(xin + (size_t)(m0 + q) * DM) + lane;
#pragma unroll
            for (int j = 0; j < 8; ++j) v[q][j] = xr[64 * j]; }
#pragma unroll
        for (int q = 0; q < 2; ++q) { float a = 0.f;
#pragma unroll
            for (int j = 0; j < 8; ++j) a += (v[q][j].x * v[q][j].x + v[q][j].y * v[q][j].y) + (v[q][j].z * v[q][j].z + v[q][j].w * v[q][j].w);
            s[q] = a; }
        s[0] = wave_sum(s[0]); s[1] = wave_sum(s[1]);
#pragma unroll
        for (int q = 0; q < 2; ++q) { const int m = m0 + q; if (lane < 8) ss[(size_t)lane * M + m] = lane == 0 ? s[q] : 0.f;
            const GAS f32x4* sc = (const GAS f32x4*)(sc0 + ((m >= SEQ) ? NMOD : 0)) + lane;
            GAS unsigned long long* o8 = (GAS unsigned long long*)(xa + (size_t)m * DM) + lane;
#pragma unroll
            for (int j = 0; j < 8; ++j) { f32x4 sg = sc[64 * j] + 1.0f;
#pragma unroll
                for (int e = 0; e < 4; ++e) sg[e] = __builtin_fabsf(sg[e]) < 1e-20f ? __builtin_copysignf(1e-20f, sg[e]) : sg[e];
                const f32x4 h = v[q][j] * sg;
                o8[64 * j] = pg8::XA_F16 ? ((unsigned long long)pk2h(h.x, h.y) | ((unsigned long long)pk2h(h.z, h.w) << 32)) : ((unsigned long long)pk2(h.x, h.y) | ((unsigned long long)pk2(h.z, h.w) << 32)); } }
    }
}
__device__ __forceinline__ void final_norm_phase(const bf16* xh, const float* ss, const float* w, float* out, int gw, int NGW, int lane) {
    const GAS f32x4* wr = (const GAS f32x4*)w + lane;
    typedef _Float16 h4 __attribute__((ext_vector_type(4)));
    for (int m0 = gw * 2; m0 < M; m0 += NGW * 2) {
        unsigned long long xv[2][8];
#pragma unroll
        for (int q = 0; q < 2; ++q) { const GAS unsigned long long* xr = (const GAS unsigned long long*)(xh + (size_t)(m0 + q) * DM) + lane;
#pragma unroll
            for (int j = 0; j < 8; ++j) xv[q][j] = xr[64 * j]; }
#pragma unroll
        for (int q = 0; q < 2; ++q) { float sq = ss[m0 + q];
#pragma unroll
            for (int j = 1; j < 8; ++j) sq += ss[(size_t)j * M + m0 + q];
            const float rstd = 1.0f / sqrtf(sq * (1.f / DM) + RMS_EPS);
            GAS f32x4* o = (GAS f32x4*)(out + (size_t)(m0 + q) * DM) + lane;
#pragma unroll
            for (int j = 0; j < 8; ++j) { const h4 hv = __builtin_bit_cast(h4, xv[q][j]);
                const f32x4 v = {(float)hv[0], (float)hv[1], (float)hv[2], (float)hv[3]}; o[64 * j] = v * rstd * wr[64 * j]; } }
    }
}
__device__ __forceinline__ float gemv2_chunk(const float* W, int N, int ch, const LAS float* cond, LAS float* red, int tid) {
    const int lane = tid & 63, wave = __builtin_amdgcn_readfirstlane(tid >> 6), cg = lane & 15, kr = lane >> 4;
    const float* wp = W + (size_t)(256 * wave + kr) * N + ch * 64 + cg * 4;
    f32x4 a0 = {0.f, 0.f, 0.f, 0.f}, a1 = {0.f, 0.f, 0.f, 0.f};
#pragma unroll 8
    for (int i = 0; i < 64; ++i) { const f32x4 w = *(const GAS f32x4*)(wp + (size_t)(4 * i) * N); const int k = 256 * wave + 4 * i + kr;
        a0 += w * cond[k]; a1 += w * cond[DM + k]; }
    { const int l = xl_lane();
#pragma unroll
    for (int e = 0; e < 4; ++e) { a0[e] += xl_xor(a0[e], l, 16); a0[e] += xl_xor(a0[e], l, 32); a1[e] += xl_xor(a1[e], l, 16); a1[e] += xl_xor(a1[e], l, 32); } }
    if (lane < 16) { *(LAS f32x4*)(red + (wave * 2 + 0) * 64 + cg * 4) = a0; *(LAS f32x4*)(red + (wave * 2 + 1) * 64 + cg * 4) = a1; }
    __syncthreads();
    float s = 0.f;
    if (tid < 128) { const int b = tid >> 6, col = tid & 63;
#pragma unroll
        for (int w = 0; w < 8; ++w) s += red[(w * 2 + b) * 64 + col]; }
    __syncthreads();
    return s;
}
__device__ __forceinline__ void kmean_phase(const bf16* proj, float* km, LAS unsigned char* lds, int vcu, int G, int tid) {
    const int wave = tid >> 6, lane = tid & 63;
    LAS float* red = (LAS float*)lds;
    for (int u = vcu; u < BATCH * 64 * 2; u += G) {
        const int half = u & 1, j = (u >> 1) & 63, b = u >> 7;
        const bf16* src = proj + ((size_t)(b * SEQ + j * 256)) * EV_IN + 1024 + half * 512 + lane * 8;
        float a[8];
#pragma unroll
        for (int e = 0; e < 8; ++e) a[e] = 0.f;
#pragma unroll 8
        for (int r = wave; r < 256; r += 8) { const v4u w = *(const GAS v4u*)(src + (size_t)r * EV_IN);
            a[0] += __uint_as_float(w.x << 16); a[1] += __uint_as_float(w.x & 0xffff0000u); a[2] += __uint_as_float(w.y << 16); a[3] += __uint_as_float(w.y & 0xffff0000u);
            a[4] += __uint_as_float(w.z << 16); a[5] += __uint_as_float(w.z & 0xffff0000u); a[6] += __uint_as_float(w.w << 16); a[7] += __uint_as_float(w.w & 0xffff0000u); }
#pragma unroll
        for (int e = 0; e < 8; ++e) red[wave * 512 + lane * 8 + e] = a[e];
        __syncthreads();
        { const int col = tid; float s = 0.f;
#pragma unroll
          for (int w = 0; w < 8; ++w) s += red[w * 512 + col];
          const int cc = half * 512 + col, h = cc >> 7, d = cc & 127;
          km[(((size_t)(b * 8 + h)) * 64 + j) * 128 + d] = s * (1.0f / 256.0f); }
        __syncthreads();
    }
}
__device__ __forceinline__ void gate_phase(const bf16* proj, const float* km, unsigned* cnt, unsigned* list, LAS unsigned char* lds, unsigned char* lds_raw, int vcu, int G, int tid) {
    LAS int* cntl = (LAS int*)(lds + 40960); LAS int* basel = cntl + 64;
    const int lane = tid & 63, r32 = lane & 31, hi = lane >> 5, wid = tid >> 6;
    for (int u = vcu; u < BATCH * 8 * 64; u += G) {
        const int i = ((u >> 8) & 1) ? 63 - (u & 63) : (u & 63), h = (u >> 6) & 7, b = u >> 9;
        if (i == 0) continue;
        if (tid < 64) cntl[tid] = 0;
        att::gate_stage_kmean(km + ((size_t)(b * 8 + h) * 64) * 128, (char*)lds_raw, tid);
        __syncthreads();
        int pk0, pk1, pk2; att::gate_top3<EV_IN>(proj + ((size_t)b * SEQ + i * 256) * EV_IN + h * 128, i, (char*)lds_raw, tid, pk0, pk1, pk2);
        const int qi = wid * 32 + r32;
        int sl0 = 0, sl1 = 0, sl2 = 0;
        if (hi == 0) { if (pk0 < 64) sl0 = __hip_atomic_fetch_add(cntl + pk0, 1, __ATOMIC_RELAXED, __HIP_MEMORY_SCOPE_WORKGROUP);
                       if (pk1 < 64) sl1 = __hip_atomic_fetch_add(cntl + pk1, 1, __ATOMIC_RELAXED, __HIP_MEMORY_SCOPE_WORKGROUP);
                       if (pk2 < 64) sl2 = __hip_atomic_fetch_add(cntl + pk2, 1, __ATOMIC_RELAXED, __HIP_MEMORY_SCOPE_WORKGROUP); }
        __syncthreads();
        if (tid < i) { const int c = cntl[tid]; basel[tid] = c > 0 ? (int)atomicAdd(cnt + (b * 8 + h) * 64 + tid, (unsigned)c) : 0; }
        __syncthreads();
        if (hi == 0) { const unsigned ent = (unsigned)(i * 256 + qi); const size_t lb = (size_t)((b * 8 + h) * 64) * 16384;
            if (pk0 < 64) list[lb + (size_t)pk0 * 16384 + basel[pk0] + sl0] = ent;
            if (pk1 < 64) list[lb + (size_t)pk1 * 16384 + basel[pk1] + sl1] = ent | (1u << 14);
            if (pk2 < 64) list[lb + (size_t)pk2 * 16384 + basel[pk2] + sl2] = ent | (2u << 14); }
        __syncthreads();
    }
}
__device__ __forceinline__ void diff_combine_phase(const bf16* ot, bf16* y, const float* lamv, const float* subln, float lam_init, int gw, int NGW, int lane) {
    float d1 = lamv[lane] * lamv[128 + lane] + lamv[64 + lane] * lamv[192 + lane];
    float d2 = lamv[256 + lane] * lamv[384 + lane] + lamv[320 + lane] * lamv[448 + lane];
    d1 = wave_sum(d1); d2 = wave_sum(d2);
    const float lam = expf(d1) - expf(d2) + lam_init;
    const f32x4 sw = *(const GAS f32x4*)(subln + 4 * lane);
    const float post = 1.0f - lam_init;
    for (int it0 = gw * 8; it0 < M * 4; it0 += NGW * 8) {
        unsigned long long w1[8], w2[8];
#pragma unroll
        for (int q = 0; q < 8; ++q) { const int it = it0 + q; const int hb = it & 3; const size_t row = (size_t)(it >> 2); const bf16* p = ot + row * DM + hb * 512 + 4 * lane;
            w1[q] = *(const GAS unsigned long long*)p; w2[q] = *(const GAS unsigned long long*)(p + 256); }
        f32x4 yb[8]; float ss[8];
#pragma unroll
        for (int q = 0; q < 8; ++q) { f32x4 a, b;
            a.x = __uint_as_float((unsigned)w1[q] << 16); a.y = __uint_as_float((unsigned)w1[q] & 0xffff0000u); a.z = __uint_as_float((unsigned)(w1[q] >> 32) << 16); a.w = __uint_as_float((unsigned)(w1[q] >> 32) & 0xffff0000u);
            b.x = __uint_as_float((unsigned)w2[q] << 16); b.y = __uint_as_float((unsigned)w2[q] & 0xffff0000u); b.z = __uint_as_float((unsigned)(w2[q] >> 32) << 16); b.w = __uint_as_float((unsigned)(w2[q] >> 32) & 0xffff0000u);
            yb[q] = a - b * lam; ss[q] = (yb[q].x * yb[q].x + yb[q].y * yb[q].y) + (yb[q].z * yb[q].z + yb[q].w * yb[q].w); }
        { const int l = xl_lane();
#pragma unroll
          for (int o = 1; o < 64; o <<= 1) {
#pragma unroll
            for (int q = 0; q < 8; ++q) ss[q] += xl_xor(ss[q], l, o); } }
#pragma unroll
        for (int q = 0; q < 8; ++q) { const int it = it0 + q; const int hb = it & 3; const size_t row = (size_t)(it >> 2);
            const float rstd = 1.0f / sqrtf(ss[q] * (1.0f / 256.0f) + SUBLN_EPS);
            const f32x4 o = yb[q] * rstd * sw * post;
            *(GAS unsigned long long*)(y + row * DM + 1024 + hb * 256 + 4 * lane) = (unsigned long long)pk2(o.x, o.y) | ((unsigned long long)pk2(o.z, o.w) << 32); }
    }
}
__device__ __forceinline__ void moba_combine_phase(const bf16* part, const float* ml, bf16* y, int gw, int NGW, int lane) {
    constexpr float C2 = 0.08838834764831845f * 1.4426950408889634f;
    const int sub = lane >> 5, c4 = (lane & 31) * 4;
    constexpr int U = 4;
    for (int it0 = gw * U; it0 < M * 8 / 2; it0 += NGW * U) {
        f32x4 ml01[U], ml23[U]; unsigned long long pv4[U][4];
#pragma unroll
        for (int q = 0; q < U; ++q) { const int item = (it0 + q) * 2 + sub;
            ml01[q] = *(const GAS f32x4*)(ml + (size_t)item * 8); ml23[q] = *(const GAS f32x4*)(ml + (size_t)item * 8 + 4);
            const bf16* p = part + (size_t)item * 512 + c4;
#pragma unroll
            for (int s = 0; s < 4; ++s) pv4[q][s] = *(const GAS unsigned long long*)(p + s * 128); }
#pragma unroll
        for (int q = 0; q < U; ++q) { const int item = (it0 + q) * 2 + sub; const int row = item >> 3, h = item & 7; const int nv = min((row & (SEQ - 1)) >> 8, 3);
            const float NEG = -__builtin_inff();
            const float m0 = nv > 0 ? ml01[q].x : NEG, m1 = nv > 1 ? ml01[q].z : NEG, m2 = nv > 2 ? ml23[q].x : NEG, m3 = ml23[q].z;
            const float mx = fmaxf(fmaxf(m0, m1), fmaxf(m2, m3));
            const float w0 = nv > 0 ? ml01[q].y * __builtin_amdgcn_exp2f((m0 - mx) * C2) : 0.f, w1 = nv > 1 ? ml01[q].w * __builtin_amdgcn_exp2f((m1 - mx) * C2) : 0.f;
            const float w2 = nv > 2 ? ml23[q].y * __builtin_amdgcn_exp2f((m2 - mx) * C2) : 0.f, w3 = ml23[q].w * __builtin_amdgcn_exp2f((m3 - mx) * C2);
            const float rw = 1.0f / ((w0 + w1) + (w2 + w3));
            f32x4 acc = {0.f, 0.f, 0.f, 0.f};
#pragma unroll
            for (int s = 0; s < 4; ++s) { const float w = s == 0 ? w0 : s == 1 ? w1 : s == 2 ? w2 : w3; const bool ok = (s == 3) || (s < nv); const unsigned long long v = pv4[q][s];
                const f32x4 t = {w * __uint_as_float((unsigned)v << 16), w * __uint_as_float((unsigned)v & 0xffff0000u), w * __uint_as_float((unsigned)(v >> 32) << 16), w * __uint_as_float((unsigned)(v >> 32) & 0xffff0000u)};
                acc.x += ok ? t.x : 0.f; acc.y += ok ? t.y : 0.f; acc.z += ok ? t.z : 0.f; acc.w += ok ? t.w : 0.f; }
            acc = acc * rw;
            *(GAS unsigned long long*)(y + (size_t)row * DM + h * 128 + c4) = (unsigned long long)pk2(acc.x, acc.y) | ((unsigned long long)pk2(acc.z, acc.w) << 32); }
    }
}

namespace swa {
typedef short bf16x8 __attribute__((ext_vector_type(8)));
typedef float f32x16 __attribute__((ext_vector_type(16)));
constexpr int KS_STRIDE = 144, VT_STRIDE = 528;
constexpr int OFF_K = 0, OFF_VT = 256 * KS_STRIDE, OFF_L = OFF_VT + 64 * VT_STRIDE, OFF_O = OFF_L + 8 * 32 * 4, O_STRIDE = 144, LDS_END = OFF_O + 8 * 32 * O_STRIDE;
static_assert(LDS_END <= RING_BYTES, "swa LDS");
__device__ __forceinline__ int crow(int r, int hi) { return (r & 3) + 8 * (r >> 2) + 4 * hi; }
__device__ __forceinline__ unsigned cvtpk(float lo, float hi) { unsigned r; asm volatile("v_cvt_pk_bf16_f32 %0, %1, %2" : "=v"(r) : "v"(lo), "v"(hi)); return r; }
__device__ __forceinline__ void phase(const bf16* proj, bf16* y, const float* sinks, LAS unsigned char* lds, int vcu, int G, int tid) {
    const int wave = __builtin_amdgcn_readfirstlane(tid >> 6), lane = tid & 63, r32 = lane & 31, hi = lane >> 5;
    constexpr float C2 = 0.125f * 1.4426950408889634f;
    for (int u = vcu; u < BATCH * 4 * 128; u += G) {
        const int bi = u & 127, kvh = (u >> 7) & 3, b = u >> 9;
        const int hq = kvh * 8 + wave;
        bf16x8 qra[4][4];
#pragma unroll
        for (int sb = 0; sb < 4; ++sb)
#pragma unroll
            for (int d0 = 0; d0 < 4; ++d0) qra[sb][d0] = *(const GAS bf16x8*)(proj + ((size_t)b * SEQ + bi * 128 + sb * 32 + r32) * OD_IN + hq * 64 + d0 * 16 + hi * 8);
        v4u kwv[4], vwv[4];
#pragma unroll
        for (int i = 0; i < 4; ++i) { const int c = tid + NTHR * i, kk = c >> 3, ch = c & 7; const int kpos = (bi - 1) * 128 + kk;
            kwv[i] = (v4u){0u, 0u, 0u, 0u}; vwv[i] = (v4u){0u, 0u, 0u, 0u};
            if (kpos >= 0) { const bf16* src = proj + ((size_t)b * SEQ + kpos) * OD_IN + 2048 + kvh * 64 + ch * 8; kwv[i] = *(const GAS v4u*)src; vwv[i] = *(const GAS v4u*)(src + 256); } }
#pragma unroll
        for (int i = 0; i < 4; ++i) { const int c = tid + NTHR * i, kk = c >> 3, ch = c & 7; const v4u kw = kwv[i], vw = vwv[i];
            *(LAS v4u*)(lds + OFF_K + kk * KS_STRIDE + ch * 16) = kw;
            LAS unsigned short* vt = (LAS unsigned short*)(lds + OFF_VT + (ch * 8) * VT_STRIDE + kk * 2);
            vt[0 * (VT_STRIDE / 2)] = (unsigned short)(vw.x & 0xffffu); vt[1 * (VT_STRIDE / 2)] = (unsigned short)(vw.x >> 16);
            vt[2 * (VT_STRIDE / 2)] = (unsigned short)(vw.y & 0xffffu); vt[3 * (VT_STRIDE / 2)] = (unsigned short)(vw.y >> 16);
            vt[4 * (VT_STRIDE / 2)] = (unsigned short)(vw.z & 0xffffu); vt[5 * (VT_STRIDE / 2)] = (unsigned short)(vw.z >> 16);
            vt[6 * (VT_STRIDE / 2)] = (unsigned short)(vw.w & 0xffffu); vt[7 * (VT_STRIDE / 2)] = (unsigned short)(vw.w >> 16); }
        __syncthreads();
        const float sinkl = sinks[hq] * 1.4426950408889634f;
        LAS float* Lw = (LAS float*)(lds + OFF_L) + wave * 32;
        LAS unsigned char* Ow = lds + OFF_O + wave * 32 * O_STRIDE;
#pragma unroll
        for (int sb = 0; sb < 4; ++sb) {
            const size_t qrow = (size_t)b * SEQ + bi * 128 + sb * 32;
            bf16x8 qr[4];
#pragma unroll
            for (int d0 = 0; d0 < 4; ++d0) qr[d0] = qra[sb][d0];
            const int t0 = sb >> 1;
            f32x16 p[3][2];
#pragma unroll
            for (int tt = 0; tt < 3; ++tt)
#pragma unroll
                for (int hf = 0; hf < 2; ++hf) { f32x16 a = {};
                    const LAS unsigned char* kb = lds + OFF_K + ((t0 + tt) * 64 + hf * 32 + r32) * KS_STRIDE + hi * 16;
#pragma unroll
                    for (int d0 = 0; d0 < 4; ++d0) { const bf16x8 kf = *(const LAS bf16x8*)(kb + d0 * 32); a = __builtin_amdgcn_mfma_f32_32x32x16_bf16(kf, qr[d0], a, 0, 0, 0); }
                    p[tt][hf] = a; }
            float mx = sinkl;
#pragma unroll
            for (int tt = 0; tt < 3; ++tt)
#pragma unroll
                for (int hf = 0; hf < 2; ++hf)
#pragma unroll
                    for (int r = 0; r < 16; ++r) { const int kk = (t0 + tt) * 64 + hf * 32 + crow(r, hi); const int rel = 128 + sb * 32 + r32 - kk;
                        const bool valid = (rel >= 0) && (rel < 128) && (bi > 0 || kk >= 128);
                        const float xv = valid ? p[tt][hf][r] * C2 : -__builtin_inff(); p[tt][hf][r] = xv; mx = fmaxf(mx, xv); }
            const int xl_ = xl_lane(); mx = fmaxf(mx, xl_xor(mx, xl_, 32));
            float ls = 0.f;
#pragma unroll
            for (int tt = 0; tt < 3; ++tt)
#pragma unroll
                for (int hf = 0; hf < 2; ++hf)
#pragma unroll
                    for (int r = 0; r < 16; ++r) { const float e = __builtin_amdgcn_exp2f(p[tt][hf][r] - mx); p[tt][hf][r] = e; ls += e; }
            ls += xl_xor(ls, xl_, 32);
            ls += __builtin_amdgcn_exp2f(sinkl - mx);
            f32x16 o[2] = {};
#pragma unroll
            for (int tt = 0; tt < 3; ++tt)
#pragma unroll
                for (int hf = 0; hf < 2; ++hf)
#pragma unroll
                    for (int s = 0; s < 2; ++s) { const f32x16& P = p[tt][hf]; const int B_ = 8 * s;
                        unsigned a0 = cvtpk(P[B_ + 0], P[B_ + 1]), a1 = cvtpk(P[B_ + 2], P[B_ + 3]), b0 = cvtpk(P[B_ + 4], P[B_ + 5]), b1 = cvtpk(P[B_ + 6], P[B_ + 7]);
                        auto r0 = __builtin_amdgcn_permlane32_swap(a0, b0, false, false); auto r1 = __builtin_amdgcn_permlane32_swap(a1, b1, false, false);
                        v4u w = {r0[0], r1[0], r0[1], r1[1]}; const bf16x8 pa = __builtin_bit_cast(bf16x8, w);
                        const int key0 = (t0 + tt) * 64 + hf * 32 + s * 16 + hi * 8;
#pragma unroll
                        for (int cb = 0; cb < 2; ++cb) { const bf16x8 vf = *(const LAS bf16x8*)(lds + OFF_VT + (cb * 32 + r32) * VT_STRIDE + key0 * 2);
                            o[cb] = __builtin_amdgcn_mfma_f32_32x32x16_bf16(pa, vf, o[cb], 0, 0, 0); } }
            if (hi == 0) Lw[r32] = ls;
            LDS_WAIT(); asm volatile("" ::: "memory");
#pragma unroll
            for (int r = 0; r < 16; ++r) { const float rl = __builtin_amdgcn_rcpf(Lw[crow(r, hi)]);
#pragma unroll
                for (int cb = 0; cb < 2; ++cb) *(LAS unsigned short*)(Ow + crow(r, hi) * O_STRIDE + (cb * 32 + r32) * 2) = (unsigned short)f2bf(o[cb][r] * rl); }
            LDS_WAIT(); asm volatile("" ::: "memory");
#pragma unroll
            for (int i = 0; i < 4; ++i) { const int c = lane + 64 * i, rr = c >> 3, ch = c & 7; const v4u w = *(const LAS v4u*)(Ow + rr * O_STRIDE + ch * 16);
                *(GAS v4u*)(y + (qrow + rr) * DM + hq * 64 + ch * 8) = w; }
            LDS_WAIT(); asm volatile("" ::: "memory");
        }
        __syncthreads();
    }
}
}

#ifndef NO_ATT
#define NO_ATT 0
#endif
#ifndef NO_SWA
#define NO_SWA 0
#endif
#ifndef NO_GATE
#define NO_GATE 0
#endif
#ifndef NO_GEMM
#define NO_GEMM 0
#endif
#ifndef NO_PRO
#define NO_PRO 0
#endif
#ifndef NO_MOBA
#define NO_MOBA 0
#endif
#ifndef DUP_MOBA
#define DUP_MOBA 0
#endif
#ifndef DUP_DIFF
#define DUP_DIFF 0
#endif
#ifndef DUP_FFIN
#define DUP_FFIN 0
#endif
#ifndef DUP_PRO
#define DUP_PRO 0
#endif
#ifndef DUP_GATE
#define DUP_GATE 0
#endif
#ifndef DUP_SWA
#define DUP_SWA 0
#endif
#ifndef DUP_NORM
#define DUP_NORM 0
#endif
#ifndef DUP_KM
#define DUP_KM 0
#endif
#ifndef DUP_COMB
#define DUP_COMB 0
#endif
#ifndef DUP_FFOUT
#define DUP_FFOUT 0
#endif
#ifndef DUP_PROB
#define DUP_PROB 0
#endif
#ifndef DUP_EVIN
#define DUP_EVIN 0
#endif
#ifndef DUP_OUTP
#define DUP_OUTP 0
#endif
#ifndef NO_DIFF
#define NO_DIFF 0
#endif
struct Ctx {
    unsigned char* ws; int G, bx, vcu; int lo, hi; int wv;
};
__device__ __forceinline__ int fresh_tid_w(int wv) { int l; asm volatile("v_mbcnt_lo_u32_b32 %0, -1, 0\n\tv_mbcnt_hi_u32_b32 %0, -1, %0" : "=v"(l)); return wv * 64 + l; }
#define fresh_tid() fresh_tid_w(C.wv)
#if MK_PER_PHASE
#define IN_RANGE(k) (C.lo <= (k) && (k) < C.hi)
#define SEAM() do { ++ph; } while (0)
#else
#define IN_RANGE(k) (true)
#ifndef DUP_BAR
#define DUP_BAR 0
#endif
#define SEAM() do { xcd_barrier(bar, fresh_tid() == 0); if (DUP_BAR) xcd_barrier(bar, fresh_tid() == 0); ++ph; } while (0)
#endif
typedef const __attribute__((address_space(4))) Args* ArgsP;
__device__ __forceinline__ ArgsP launder_args(ArgsP p) { asm volatile("" : "+s"(p)); return p; }
#define A_ (*launder_args(ap))
#define WSP(T, off) ((T*)(A_.ws + (off)))

template <int L>
__device__ __forceinline__ void layer_phases(ArgsP ap, const Ctx& C, const XcdBarrier& bar, int& ph, unsigned char* lds_raw) {
    LAS unsigned char* lds = (LAS unsigned char*)lds_raw;
    constexpr int li = L >> 1; constexpr bool even = (L & 1) == 0;
#define mod (WSP(const float, WS_MOD) + (size_t)L * 2 * NMOD)
    if constexpr (even) {
        for (int rep_ = 0; rep_ < 1 + (L == 0 ? DUP_EVIN : 0); ++rep_)
        if (IN_RANGE(ph)) { if constexpr (!NO_GEMM) {
            pg8::Gemm g{WSP(const bf16, WS_XH), WSP(const bf16, W_EVIN) + (size_t)li * DM * EV_IN, M, EV_IN, DM}; pg8::StaticOrder S; S.init(M, EV_IN, C.G, C.bx);
            pg8::EpiEvenIn E{WSP(bf16, WS_PROJ), WSP(const _Float16, WS_ROPE), WSP(const float, WS_SSP) + (size_t)(2 * L) * 8 * M, WSP(const float, WS_BIAS) + (size_t)((L * 2 + 0) * 2) * pg8::BIAS_BSTRIDE, (LAS float*)(lds + LDSCTL_OFF + 6144)};
            pg8::gemm_phase<pg8::EpiEvenIn, pg8::StaticOrder, true, true>(lds + RING_OFF, g, S, E, C.wv); } }
        SEAM();
        for (int rep_ = 0; rep_ < 1 + (L == 0 ? DUP_KM : 0); ++rep_) if (IN_RANGE(ph)) kmean_phase(WSP(const bf16, WS_PROJ), WSP(float, WS_KM), lds, C.vcu, C.G, fresh_tid());
        SEAM();
        if (IN_RANGE(ph)) { if constexpr (!NO_GATE) gate_phase(WSP(const bf16, WS_PROJ), WSP(const float, WS_KM), WSP(unsigned, WS_CTL) + CW_CNT + li * 1024, WSP(unsigned, WS_LIST), lds, lds_raw, C.vcu, C.G, fresh_tid()); }
        if constexpr (L == 0 && DUP_GATE) { __syncthreads(); gate_phase(WSP(const bf16, WS_PROJ), WSP(const float, WS_KM), WSP(unsigned, WS_CTL) + CW_CNT + 4096, WSP(unsigned, WS_PART), lds, lds_raw, C.vcu, C.G, fresh_tid()); }
        SEAM();
        if (IN_RANGE(ph)) { if constexpr (!NO_ATT) {
            const int xcd = C.vcu >> 5, ci = C.vcu & 31;
            bf16* PROJ = WSP(bf16, WS_PROJ);
            for (int rep_ = 0; rep_ < 1 + (L == 0 ? DUP_MOBA : 0); ++rep_) if constexpr (!NO_MOBA) {
                const int atid = fresh_tid();
                const unsigned* CNT = WSP(const unsigned, WS_CTL) + CW_CNT + li * 1024; const unsigned* LIST = WSP(const unsigned, WS_LIST);
                bf16* PART = WSP(bf16, WS_PART); float* ML = WSP(float, WS_ML);
                LAS unsigned short* pre = (LAS unsigned short*)(lds + LDSCTL_OFF + 3072);
                if (atid < 64) { int loc[16]; int s = 0;
#pragma unroll
                    for (int k = 0; k < 16; ++k) { loc[k] = s; s += (int)((CNT[atid * 16 + k] + 255u) >> 8) + 1; }
                    pre[1040 + atid] = (unsigned short)s; asm volatile("s_waitcnt lgkmcnt(0)" ::: "memory");
                    int base = 0;
                    for (int k = 0; k < atid; ++k) base += pre[1040 + k];
#pragma unroll
                    for (int k = 0; k < 16; ++k) pre[atid * 16 + k] = (unsigned short)(base + loc[k]);
                    if (atid == 63) pre[1024] = (unsigned short)(base + s); }
                __syncthreads();
                const int T = pre[1024];
                unsigned Gq = (unsigned)C.G; asm volatile("" : "+s"(Gq));
                const unsigned tq_ = (unsigned)T / Gq, tr_ = (unsigned)T - tq_ * Gq;
                const int t_begin = (int)((unsigned)C.vcu * tq_ + min((unsigned)C.vcu, tr_)), t_end = (int)((unsigned)(C.vcu + 1) * tq_ + min((unsigned)(C.vcu + 1), tr_));
                auto ref = [&](int t, int& key) { att::SparseRef r;
                    int lo_ = 0, hi_ = 1024;
                    while (hi_ - lo_ > 1) { const int mid = (lo_ + hi_) >> 1; if ((int)pre[mid] <= t) lo_ = mid; else hi_ = mid; }
                    const int e = __builtin_amdgcn_readfirstlane(lo_), idx = t - __builtin_amdgcn_readfirstlane((int)pre[lo_]); const int b = e >> 9, h = (e >> 6) & 7, j = e & 63;
                    const int cnt_e = (int)CNT[e], ntile = (cnt_e + 255) >> 8; const size_t rb = (size_t)b * SEQ;
                    r.Qb = PROJ + rb * EV_IN + h * 128; r.K = PROJ + (rb + j * 256) * EV_IN + 1024 + h * 128; r.V = r.K + 1024; r.dbase = (unsigned)((b * SEQ * 8 + h) * 4);
                    if (idx < ntile) { r.list = LIST + (size_t)e * 16384 + idx * 256; r.q0 = 0; r.nrows = cnt_e - idx * 256; r.causal = 0; }
                    else { r.list = nullptr; r.q0 = j * 256; r.nrows = 256; r.causal = 1; }
                    key = e; return r; };
                if (t_begin < t_end) {
                    int cur_key = -1, key = 0, nkey = 0, bank = 0; att::bf16x8 qr[8];
                    att::SparseRef cur = ref(t_begin, key);
                    att::sparse2_prime(cur, (char*)lds_raw, atid, qr, EV_IN);
                    for (int t = t_begin; t < t_end; ++t) {
                        const bool has_next = t + 1 < t_end; const att::SparseRef nxt = has_next ? ref(t + 1, nkey) : cur;
                        if (key != cur_key) { __syncthreads(); att::sparse2_stage<EV_IN>(cur.K, cur.V, (char*)lds_raw, atid); __syncthreads(); cur_key = key; }
                        att::sparse2_wave<EV_IN>(cur, nxt, has_next, bank, PART, ML, (char*)lds_raw, atid, qr);
                        cur = nxt; key = nkey; bank ^= 1;
                    }
                }
            }
            for (int rep_ = 0; rep_ < 1 + (L == 0 ? DUP_DIFF : 0); ++rep_) if constexpr (!NO_DIFF) {
                const int atid = fresh_tid();
                bf16* OT = WSP(bf16, WS_OT);
                __syncthreads();
                for (int n = 0; n < 4; ++n) { const int vh = 2 * xcd + (n >> 1), b = vh >> 3, hb = (vh >> 1) & 3, mp = vh & 1, qb = (n & 1) ? 63 - ci : ci; att::Block2Ref r;
                    const size_t rq = (size_t)b * SEQ + qb * 256;
                    r.Q = PROJ + rq * EV_IN + 3072 + (hb * 2 + mp) * 128; r.K = PROJ + (size_t)b * SEQ * EV_IN + 4096 + (hb * 2 + mp) * 128; r.V = PROJ + (size_t)b * SEQ * EV_IN + 5120 + hb * 256;
                    r.O = OT + rq * DM + hb * 512 + mp * 256; r.P0 = qb * 256;
                    att::causal_block2<EV_IN, DM>(r, (char*)lds_raw, atid); }
            }
        } }
        SEAM();
        for (int rep_ = 0; rep_ < 1 + (L == 0 ? DUP_COMB : 0); ++rep_) if (IN_RANGE(ph)) { const int tid = fresh_tid(), lane = tid & 63, wave = __builtin_amdgcn_readfirstlane(tid >> 6);
            diff_combine_phase(WSP(const bf16, WS_OT), WSP(bf16, WS_Y), A_.diff_lambda + li * 512, A_.diff_subln + li * 256, A_.lam_init[L], C.vcu * NWAVES + wave, C.G * NWAVES, lane);
            moba_combine_phase(WSP(const bf16, WS_PART), WSP(const float, WS_ML), WSP(bf16, WS_Y), C.vcu * NWAVES + wave, C.G * NWAVES, lane); }
        SEAM();
        if (IN_RANGE(ph)) { if constexpr (!NO_GEMM) {
            pg8::Gemm g{WSP(const bf16, WS_Y), WSP(const bf16, W_EVOUT) + (size_t)li * DM * DM, M, DM, DM}; pg8::StaticOrder S; S.init(M, DM, C.G, C.bx);
            using Epi = pg8::EpiResidH<false, true>;
            Epi E{(const void*)WSP(const bf16, WS_XH), WSP(bf16, WS_XH), WSP(bf16, WS_OT), mod + 2 * DM, nullptr, mod + 1 * DM, mod + 4 * DM, WSP(float, WS_SSP) + (size_t)(2 * L + 1) * 8 * M, (LAS float*)(lds + LDSCTL_OFF + 2048)};
            pg8::gemm_phase<Epi, pg8::StaticOrder, true, true>(lds + RING_OFF, g, S, E, C.wv); } }
        SEAM();
    } else {
        if (IN_RANGE(ph)) { if constexpr (!NO_GEMM) {
            pg8::Gemm g{WSP(const bf16, WS_XH), WSP(const bf16, W_ODIN) + (size_t)li * DM * OD_IN, M, OD_IN, DM}; pg8::StaticOrder S; S.init(M, OD_IN, C.G, C.bx);
            pg8::EpiOddIn E{WSP(bf16, WS_PROJ), WSP(const _Float16, WS_ROPE) + SEQ * 128, WSP(const float, WS_SSP) + (size_t)(2 * L) * 8 * M, WSP(const float, WS_BIAS) + (size_t)((L * 2 + 0) * 2) * pg8::BIAS_BSTRIDE, (LAS float*)(lds + LDSCTL_OFF + 6144)};
            pg8::gemm_phase<pg8::EpiOddIn, pg8::StaticOrder, true, true>(lds + RING_OFF, g, S, E, C.wv); } }
        SEAM();
        for (int rep_ = 0; rep_ < 1 + (L == 1 ? DUP_SWA : 0); ++rep_) if (IN_RANGE(ph)) { if constexpr (!NO_SWA) swa::phase(WSP(const bf16, WS_PROJ), WSP(bf16, WS_Y), A_.swa_sinks + li * 32, lds, C.vcu, C.G, fresh_tid()); }
        SEAM();
        if (IN_RANGE(ph)) { if constexpr (!NO_GEMM) {
            pg8::Gemm g{WSP(const bf16, WS_Y), WSP(const bf16, W_ODOUT) + (size_t)li * DM * DM, M, DM, DM}; pg8::StaticOrder S; S.init(M, DM, C.G, C.bx);
            using Epi = pg8::EpiResidH<false, true>;
            Epi E{(const void*)WSP(const bf16, WS_XH), WSP(bf16, WS_XH), WSP(bf16, WS_OT), mod + 2 * DM, A_.swa_b_out + li * DM, mod + 1 * DM, mod + 4 * DM, WSP(float, WS_SSP) + (size_t)(2 * L + 1) * 8 * M, (LAS float*)(lds + LDSCTL_OFF + 2048)};
            pg8::gemm_phase<Epi, pg8::StaticOrder, true, true>(lds + RING_OFF, g, S, E, C.wv); } }
        SEAM();
    }
    for (int rep_ = 0; rep_ < 1 + (L == 0 ? DUP_FFIN : 0); ++rep_)
    if (IN_RANGE(ph)) { if constexpr (!NO_GEMM) {
        pg8::Gemm g{WSP(const bf16, WS_XH), WSP(const bf16, W_FFIN) + (size_t)L * DM * FF2, M, FF2, DM}; pg8::StaticOrder S; S.init(M, FF2, C.G, C.bx);
        pg8::EpiFfnIn E{WSP(bf16, WS_PROJ), WSP(const float, WS_SSP) + (size_t)(2 * L + 1) * 8 * M, WSP(const float, WS_BIAS) + (size_t)((L * 2 + 1) * 2) * pg8::BIAS_BSTRIDE, (LAS float*)(lds + LDSCTL_OFF + 6144)};
        pg8::gemm_phase<pg8::EpiFfnIn, pg8::StaticOrder, true, true>(lds + RING_OFF, g, S, E, C.wv); } }
    SEAM();
    if (IN_RANGE(ph)) { if constexpr (!NO_GEMM) {
        pg8::Gemm g{WSP(const bf16, WS_PROJ), WSP(const bf16, W_FFOUT) + (size_t)L * FFH * DM, M, DM, FFH}; pg8::StaticOrder S; S.init(M, DM, C.G, C.bx);
        using Epi = pg8::EpiResidH<false, (L < DEPTH - 1)>;
        Epi E{(const void*)WSP(const bf16, WS_XH), WSP(bf16, WS_XH), WSP(bf16, WS_OT)  , mod + 5 * DM, nullptr, mod + 4 * DM, (L < DEPTH - 1) ? mod + 2 * NMOD + 1 * DM : mod + 4 * DM, WSP(float, WS_SSP) + (size_t)(2 * L + 2) * 8 * M, (LAS float*)(lds + LDSCTL_OFF + 2048)};
        pg8::gemm_phase<Epi, pg8::StaticOrder, true, true>(lds + RING_OFF, g, S, E, C.wv); } }
    SEAM();
}

#undef mod
__device__ __forceinline__ void prologue_phase(ArgsP ap, const Ctx& C, unsigned char* lds_raw) {
    const __attribute__((address_space(4))) Args& args = *launder_args(ap);
    LAS unsigned char* lds = (LAS unsigned char*)lds_raw;
    const int tid = fresh_tid(), lane = tid & 63, wave = __builtin_amdgcn_readfirstlane(tid >> 6);
    const int G = C.G, vcu = C.vcu, gw = vcu * NWAVES + wave, NGW = G * NWAVES;
    unsigned char* ws = args.ws;
    float* MOD = WSP(float, WS_MOD);
    _Float16* T128 = WSP(_Float16, WS_ROPE); _Float16* T64 = T128 + SEQ * 128;
    LAS float* cond = (LAS float*)(lds + 73728);
    LAS float* red = (LAS float*)(lds + 90112);
    for (int e = tid; e < 2 * DM; e += NTHR) { const float cv = args.c[e]; cond[e] = cv / (1.0f + __expf(-cv)); }
    __syncthreads();
    for (int it = vcu; it < DEPTH * (NMOD / 64); it += G) {
        const int l = it / (NMOD / 64), ch = it % (NMOD / 64);
        const float s = gemv2_chunk(args.ada_w + (size_t)l * DM * NMOD, NMOD, ch, cond, red, tid);
        if (tid < 128) { const int b = tid >> 6, col = tid & 63; MOD[((size_t)l * 2 + b) * NMOD + ch * 64 + col] = s + args.ada_b[(size_t)l * NMOD + ch * 64 + col]; }
    }
    for (int e = gw * 64 + lane; e < SEQ * 64; e += NGW * 64) { const int pos = e >> 6, i = e & 63; const float ang = (float)pos * args.invf128[i]; double s, c; dsincos((double)ang, s, c); _Float16* t = T128 + ((size_t)((pos >> 4) * 8 + (i >> 3)) * 32 + (pos & 15)) * 8 + (i & 7); t[0] = (_Float16)(float)c; t[128] = (_Float16)(float)s; }
    for (int e = gw * 64 + lane; e < SEQ * 32; e += NGW * 64) { const int pos = e >> 5, i = e & 31; const float ang = (float)pos * args.invf64[i]; double s, c; dsincos((double)ang, s, c); _Float16* t = T64 + ((size_t)((pos >> 4) * 4 + (i >> 3)) * 32 + (pos & 15)) * 8 + (i & 7); t[0] = (_Float16)(float)c; t[128] = (_Float16)(float)s; }
}


__device__ __forceinline__ void prologue_b_phase(ArgsP ap, const Ctx& C, unsigned char* lds_raw) {
    const __attribute__((address_space(4))) Args& args = *launder_args(ap);
    LAS unsigned char* lds = (LAS unsigned char*)lds_raw;
    const int tid = fresh_tid(), lane = tid & 63, wave = __builtin_amdgcn_readfirstlane(tid >> 6);
    const int G = C.G, vcu = C.vcu, gw = vcu * NWAVES + wave, NGW = G * NWAVES;
    unsigned char* ws = args.ws;
    const float* MOD = (const float*)(ws + WS_MOD); float* BIAS = (float*)(ws + WS_BIAS);
    LAS float* scr = (LAS float*)(lds + wave * 8704);
    for (int s = gw; s < 1952; s += NGW) {
        int r = s, Lk, kind; const float* W; int N; bf16* WT;
        if (r < 384) { const int i = r / 192; r -= i * 192; Lk = 2 * i; kind = 0; N = EV_IN; W = args.ab_w_in + (size_t)i * DM * N; WT = (bf16*)(ws + W_EVIN) + (size_t)i * DM * N; }
        else if ((r -= 384) < 160) { const int i = r / 80; r -= i * 80; Lk = 2 * i + 1; kind = 0; N = OD_IN; W = args.swa_w_in + (size_t)i * DM * N; WT = (bf16*)(ws + W_ODIN) + (size_t)i * DM * N; }
        else { r -= 160; const int l = r / 352; r -= l * 352; Lk = l; kind = 1; N = FF2; W = args.ffn_w_in + (size_t)l * DM * N; WT = (bf16*)(ws + W_FFIN) + (size_t)l * DM * N; }
        const float* sh0 = MOD + (size_t)Lk * 2 * NMOD + (kind ? 3 * DM : 0);
        const int nblk = N / 32; f32x4 pb[2] = {{0.f, 0.f, 0.f, 0.f}, {0.f, 0.f, 0.f, 0.f}};
        if (kind == 1) p0_run<3, pg8::XA_F16, true>(W, DM, N, WT, scr, lane, r, nblk, DM / 64, sh0, pb);
        else if (Lk & 1) p0_run<2, pg8::XA_F16, true>(W, DM, N, WT, scr, lane, r, nblk, DM / 64, sh0, pb);
        else p0_run<1, pg8::XA_F16, true>(W, DM, N, WT, scr, lane, r, nblk, DM / 64, sh0, pb);
        { const int l_ = xl_lane();
#pragma unroll
          for (int b = 0; b < 2; ++b)
#pragma unroll
            for (int q = 0; q < 4; ++q) { float v = pb[b][q]; v += xl_xor(v, l_, 8); v += xl_xor(v, l_, 16); v += xl_xor(v, l_, 32); pb[b][q] = v; } }
        if (lane < 8) {
#pragma unroll
            for (int q = 0; q < 4; ++q) { const int n = r * 32 + 4 * lane + q; int dst; float add = 0.f;
                if (kind == 1) dst = pg8::perm_ffn_in(n); else if (Lk & 1) { dst = pg8::perm_odd_in(n); add = args.swa_b_in[(Lk >> 1) * OD_IN + n]; } else dst = pg8::perm_even_in(n);
                BIAS[(size_t)((Lk * 2 + kind) * 2 + 0) * pg8::BIAS_BSTRIDE + dst] = pb[0][q] + add; BIAS[(size_t)((Lk * 2 + kind) * 2 + 1) * pg8::BIAS_BSTRIDE + dst] = pb[1][q] + add; } }
    }
    { int base = 1952 * 32;
      for (int i = 0; i < 2; ++i) {
        { const int K = DM, N = DM, NI = (K / 64) * (N / 32); const float* W = args.ab_w_out + (size_t)i * K * N; bf16* WT = (bf16*)(ws + W_EVOUT) + (size_t)i * K * N;
          { const int st_ = ((gw - base) % NGW + NGW) % NGW; p0_run<0, false, false>(W, K, N, WT, scr, lane, st_, NGW, st_ < NI ? (NI - st_ + NGW - 1) / NGW : 0); } base += NI; }
        { const int K = DM, N = DM, NI = (K / 64) * (N / 32); const float* W = args.swa_w_out + (size_t)i * K * N; bf16* WT = (bf16*)(ws + W_ODOUT) + (size_t)i * K * N;
          { const int st_ = ((gw - base) % NGW + NGW) % NGW; p0_run<0, false, false>(W, K, N, WT, scr, lane, st_, NGW, st_ < NI ? (NI - st_ + NGW - 1) / NGW : 0); } base += NI; } }
      for (int l = 0; l < DEPTH; ++l) { const int K = FFH, N = DM, NI = (K / 64) * (N / 32); const float* W = args.ffn_w_out + (size_t)l * K * N; bf16* WT = (bf16*)(ws + W_FFOUT) + (size_t)l * K * N;
          { const int st_ = ((gw - base) % NGW + NGW) % NGW; p0_run<0, false, false>(W, K, N, WT, scr, lane, st_, NGW, st_ < NI ? (NI - st_ + NGW - 1) / NGW : 0); } base += NI; } }
    first_norm_phase(args.x, MOD + 1 * DM, (bf16*)(ws + WS_XH), (float*)(ws + WS_SSP), gw, NGW, lane);
}

__global__ void __launch_bounds__(NTHR, 2) trunk_fwd(Args args) {
    extern __shared__ __attribute__((aligned(16))) unsigned char lds_raw[];
    LAS unsigned char* lds = (LAS unsigned char*)lds_raw;
    volatile LAS unsigned* MISC = (volatile LAS unsigned*)(lds + MISC_OFF);
    ArgsP ap = (ArgsP)__builtin_amdgcn_kernarg_segment_ptr();
    Ctx C; C.ws = nullptr; C.G = gridDim.x; C.bx = blockIdx.x; C.vcu = (C.G % 8 == 0) ? (C.bx % 8) * (C.G / 8) + C.bx / 8 : C.bx; C.lo = args.ph_lo; C.hi = args.ph_hi; C.wv = __builtin_amdgcn_readfirstlane(threadIdx.x >> 6);
    { const int tid = threadIdx.x; for (int u = tid; u < (LDS_BYTES - LDSCTL_OFF) / 4; u += NTHR) ((LAS unsigned*)(lds + LDSCTL_OFF))[u] = 0u; }
    __syncthreads();
#if MK_PER_PHASE
    XcdBarrier bar; bar.bar = nullptr; bar.x = 0; bar.st = nullptr; bar.G = 0;
#else
    XcdBarrier bar = xcd_barrier_post((unsigned*)(args.ws + WS_CTL) + CW_BAR, MISC + 8, threadIdx.x == 0);
#endif
    int ph = 0;
    for (int rep_ = 0; rep_ < 1 + DUP_PRO; ++rep_) { if (IN_RANGE(ph)) { if constexpr (!NO_PRO) prologue_phase(ap, C, lds_raw); } __syncthreads(); }
    SEAM();
    for (int rep_ = 0; rep_ < 1 + DUP_PROB; ++rep_) { if (IN_RANGE(ph)) { if constexpr (!NO_PRO) prologue_b_phase(ap, C, lds_raw); } __syncthreads(); }
    SEAM();
    layer_phases<0>(ap, C, bar, ph, lds_raw);
#if NLAYERS_RUN > 1
    layer_phases<1>(ap, C, bar, ph, lds_raw);
    layer_phases<2>(ap, C, bar, ph, lds_raw);
    layer_phases<3>(ap, C, bar, ph, lds_raw);
#endif
    if (IN_RANGE(ph)) { const int tid = fresh_tid(), lane = tid & 63, wave = __builtin_amdgcn_readfirstlane(tid >> 6); final_norm_phase(WSP(const bf16, WS_OT), WSP(const float, WS_SSP) + (size_t)8 * 8 * M, A_.final_norm, A_.out, C.vcu * NWAVES + wave, C.G * NWAVES, lane); }
}
#undef IN_RANGE
#undef SEAM
#undef WSP
#undef A_
constexpr int N_PHASES = 2 + 2 * 8 + 2 * 5 + 1;

extern "C" void kernel_launch(void* const* d_in, const int* in_sizes, int n_in, void* d_out, int out_size, void* d_ws, size_t ws_size, hipStream_t stream) {
    static int grid = 0;
    if (grid == 0) {
        if (n_in != 16 || in_sizes[0] != M * DM || out_size != M * DM || ws_size < WS_END) { fprintf(stderr, "kernel_launch: unexpected shapes (n_in %d, in0 %d, out %d, ws %zu < %zu); nothing launched\n", n_in, n_in > 0 ? in_sizes[0] : -1, out_size, ws_size, (size_t)WS_END); grid = -1; return; }
        int dev = 0, cus = 0, per_cu = 0;
        if (hipGetDevice(&dev) != hipSuccess || hipDeviceGetAttribute(&cus, hipDeviceAttributeMultiprocessorCount, dev) != hipSuccess) { fprintf(stderr, "kernel_launch: device query failed\n"); grid = -1; return; }
        if (hipFuncSetAttribute((const void*)trunk_fwd, hipFuncAttributeMaxDynamicSharedMemorySize, LDS_BYTES) != hipSuccess) { fprintf(stderr, "kernel_launch: hipFuncSetAttribute failed\n"); grid = -1; return; }
        if (hipOccupancyMaxActiveBlocksPerMultiprocessor(&per_cu, (const void*)trunk_fwd, NTHR, LDS_BYTES) != hipSuccess || per_cu < 1) fprintf(stderr, "kernel_launch: note: occupancy query reports %d workgroups per CU\n", per_cu);
        (void)hipGetLastError();
        grid = cus;
        if (grid != 256) fprintf(stderr, "kernel_launch: built for 256 CUs, device has %d\n", grid);
    }
    if (grid < 0) return;
    if (hipMemsetAsync((char*)d_ws + WS_CTL, 0, CTL_ZERO_BYTES, stream) != hipSuccess) { fprintf(stderr, "kernel_launch: memset failed\n"); return; }
    Args a{};
    a.x = (const float*)d_in[0]; a.c = (const float*)d_in[1]; a.ada_w = (const float*)d_in[2]; a.ada_b = (const float*)d_in[3]; a.ab_w_in = (const float*)d_in[4]; a.ab_w_out = (const float*)d_in[5];
    a.diff_lambda = (const float*)d_in[6]; a.diff_subln = (const float*)d_in[7]; a.swa_w_in = (const float*)d_in[8]; a.swa_b_in = (const float*)d_in[9]; a.swa_w_out = (const float*)d_in[10];
    a.swa_b_out = (const float*)d_in[11]; a.swa_sinks = (const float*)d_in[12]; a.ffn_w_in = (const float*)d_in[13]; a.ffn_w_out = (const float*)d_in[14]; a.final_norm = (const float*)d_in[15];
    a.out = (float*)d_out; a.ws = (unsigned char*)d_ws;
    for (int i = 0; i < 64; ++i) a.invf128[i] = powf(10000.0f, -((float)(2 * i) / 128.0f));
    for (int i = 0; i < 32; ++i) a.invf64[i] = powf(10000.0f, -((float)(2 * i) / 64.0f));
    for (int l = 0; l < 4; ++l) a.lam_init[l] = (float)(0.8 - 0.6 * exp(-0.3 * (double)l));
#if MK_PER_PHASE
    for (int p = 0; p < N_PHASES; ++p) { a.ph_lo = p; a.ph_hi = p + 1; hipLaunchKernelGGL(trunk_fwd, dim3(grid), dim3(NTHR), LDS_BYTES, stream, a); }
#else
    a.ph_lo = 0; a.ph_hi = N_PHASES;
    hipLaunchKernelGGL(trunk_fwd, dim3(grid), dim3(NTHR), LDS_BYTES, stream, a);
#endif
    const hipError_t le = hipPeekAtLastError();
    if (le != hipSuccess) fprintf(stderr, "kernel_launch: launch failed: %s\n", hipGetErrorName(le));
}
```
